# Optimizing an MI355X kernel written in HIP

```python
import math, functools
import jax, jax.numpy as jnp
from jax import lax
import numpy as np

D_MODEL = 2048
BATCH = 4
SEQ = 2048
DEPTH = 1
DEC_BATCH = 32
DEC_SEQ = 4
PAST_LEN = 16384
PAGE_SIZE = 128

D_MIX = D_MODEL
D_CONV = D_MIX // 4
D_ATTN = D_MIX - D_CONV
HEAD_DIM = 128
N_HEADS = D_ATTN // HEAD_DIM
PATTERNS = ((128, 1), (512, 4), (2048, 16))
MAX_WINDOW = max(w for w, _ in PATTERNS)
Q_BLOCK = 128
CONV_WIDTH = 31
N_BUCKETS = 32
MAX_EXACT = 16
MAX_DISTANCE = MAX_WINDOW
EPS = 1e-6
NEG_INF = -1e30
D_IN = 4 * D_ATTN + 3 * D_CONV
SPLIT_POINTS = (D_ATTN, 2 * D_ATTN, 3 * D_ATTN, 4 * D_ATTN, 4 * D_ATTN + D_CONV, 4 * D_ATTN + 2 * D_CONV)

kernel_name = "hymba_dilated_attn_conformer_conv_step"


def rms_norm(x, g):
    xf = x.astype(jnp.float32)
    y = xf * lax.rsqrt(jnp.mean(xf * xf, axis=-1, keepdims=True) + EPS)
    return (y * g.astype(jnp.float32)).astype(x.dtype)


def layer_norm(x, g, b):
    xf = x.astype(jnp.float32)
    mu = jnp.mean(xf, axis=-1, keepdims=True)
    var = jnp.mean(jnp.square(xf - mu), axis=-1, keepdims=True)
    y = (xf - mu) * lax.rsqrt(var + EPS)
    return (y * g.astype(jnp.float32) + b.astype(jnp.float32)).astype(x.dtype)


def rel_bucket(dist):
    d = jnp.maximum(dist, 1).astype(jnp.float32)
    log_b = MAX_EXACT + (jnp.log(d / MAX_EXACT) / math.log(MAX_DISTANCE / MAX_EXACT)
                         * (N_BUCKETS - MAX_EXACT)).astype(jnp.int32)
    log_b = jnp.minimum(log_b, N_BUCKETS - 1)
    return jnp.where(dist < MAX_EXACT, dist, log_b)


def masked_softmax_lse(s, valid):
    s = jnp.where(valid, s, NEG_INF)
    m = jnp.max(s, axis=-1, keepdims=True)
    p = jnp.exp(s - m)
    den = jnp.sum(p, axis=-1, keepdims=True)
    return p / den, (m + jnp.log(den))[..., 0]


def dilated_prompt(q, k, v, rel_bias, window, dilation):
    B, S, H, Dh = q.shape
    K = window // dilation
    L = S // dilation
    nb = -(-L // Q_BLOCK)
    Lp = nb * Q_BLOCK
    scale = HEAD_DIM ** -0.5

    def phases(t):
        return t.reshape(B, L, dilation, H, Dh).transpose(0, 2, 1, 3, 4)

    qb = jnp.pad(phases(q), ((0, 0), (0, 0), (0, Lp - L), (0, 0), (0, 0)))
    qb = qb.reshape(B, dilation, nb, Q_BLOCK, H, Dh)
    pad_kv = ((0, 0), (0, 0), (K, Lp - L), (0, 0), (0, 0))
    kp = jnp.pad(phases(k), pad_kv)
    vp = jnp.pad(phases(v), pad_kv)
    idx = jnp.arange(nb)[:, None] * Q_BLOCK + jnp.arange(Q_BLOCK + K)[None, :]
    kb = kp[:, :, idx]
    vb = vp[:, :, idx]
    a = jnp.arange(Q_BLOCK)[:, None]
    c = jnp.arange(Q_BLOCK + K)[None, :]
    kdist = a + K - c
    key_sub = jnp.arange(nb)[:, None, None] * Q_BLOCK + c[None] - K
    valid = (kdist >= 0) & (kdist <= K) & (key_sub >= 0)
    bias = rel_bias[rel_bucket(jnp.clip(kdist, 0, K) * dilation)]
    s = jnp.einsum('bpnqhd,bpnkhd->bpnhqk', qb, kb, preferred_element_type=jnp.float32) * scale
    s = s + bias.astype(jnp.float32).transpose(2, 0, 1)[None, None, None]
    p, lse = masked_softmax_lse(s, valid[None, None, :, None])
    o = jnp.einsum('bpnhqk,bpnkhd->bpnqhd', p.astype(v.dtype), vb)
    o = o.reshape(B, dilation, Lp, H, Dh)[:, :, :L].transpose(0, 2, 1, 3, 4).reshape(B, S, H, Dh)
    lse = lse.transpose(0, 1, 2, 4, 3).reshape(B, dilation, Lp, H)[:, :, :L]
    lse = lse.transpose(0, 2, 1, 3).reshape(B, S, H)
    return o, lse


def dilated_sample(q, k_all, v_all, past_rows, rel_bias, window, dilation):
    T = q.shape[1]
    K = window // dilation
    scale = HEAD_DIM ** -0.5
    kk = jnp.arange(K + 1)
    rows = past_rows + jnp.arange(T)[:, None] - kk[None, :] * dilation
    valid = rows >= 0
    rows_c = jnp.maximum(rows, 0)
    kg = k_all[:, rows_c]
    vg = v_all[:, rows_c]
    bias = rel_bias[rel_bucket(kk * dilation)].astype(jnp.float32)
    s = jnp.einsum('bthd,btkhd->bthk', q, kg, preferred_element_type=jnp.float32) * scale
    s = s + bias.T[None, None]
    p, lse = masked_softmax_lse(s, valid[None, :, None, :])
    o = jnp.einsum('bthk,btkhd->bthd', p.astype(v_all.dtype), vg)
    return o, lse


def combine_patterns(outs, lses, dtype):
    w = jax.nn.softmax(jnp.stack(lses, axis=0), axis=0)
    o = jnp.sum(w[..., None] * jnp.stack(outs, axis=0).astype(jnp.float32), axis=0)
    return o.astype(dtype)


def attend_prompt(q, k, v, rel_bias):
    outs, lses = [], []
    for window, dilation in PATTERNS:
        o, lse = dilated_prompt(q, k, v, rel_bias, window, dilation)
        outs.append(o)
        lses.append(lse)
    return combine_patterns(outs, lses, q.dtype)


def attend_sample(q, k, v, kv_buf, rel_bias):
    past_rows = kv_buf.shape[1]
    k_all = jnp.concatenate([kv_buf[:, :, 0], k], axis=1)
    v_all = jnp.concatenate([kv_buf[:, :, 1], v], axis=1)
    outs, lses = [], []
    for window, dilation in PATTERNS:
        o, lse = dilated_sample(q, k_all, v_all, past_rows, rel_bias, window, dilation)
        outs.append(o)
        lses.append(lse)
    return combine_patterns(outs, lses, q.dtype)


def depthwise_causal_conv(u_pad, w, b):
    C = u_pad.shape[-1]
    y = lax.conv_general_dilated(u_pad, w[:, None, :], window_strides=(1,), padding='VALID',
                                 dimension_numbers=('NWC', 'WIO', 'NWC'), feature_group_count=C)
    return y + b


def mixer_sublayer(x, conv_prefix, attend, norm_pre, w_in, conv_dw_w, conv_dw_b, conv_ln_g,
                   conv_ln_b, conv_pw_w, conv_pw_b, w_out, norm_post):
    N, T, _ = x.shape
    h = rms_norm(x, norm_pre)
    z = jnp.einsum('btd,de->bte', h, w_in)
    q, k, v, g_att, c_a, c_b, g_conv = jnp.split(z, SPLIT_POINTS, axis=-1)
    q = q.reshape(N, T, N_HEADS, HEAD_DIM)
    k = k.reshape(N, T, N_HEADS, HEAD_DIM)
    v = v.reshape(N, T, N_HEADS, HEAD_DIM)
    att = attend(q, k, v).reshape(N, T, D_ATTN)
    u = c_a * jax.nn.sigmoid(c_b)
    u_pad = jnp.concatenate([conv_prefix, u], axis=1)
    c = depthwise_causal_conv(u_pad, conv_dw_w, conv_dw_b)
    c = jax.nn.silu(layer_norm(c, conv_ln_g, conv_ln_b))
    c = jnp.einsum('btc,ce->bte', c, conv_pw_w) + conv_pw_b
    mix = jnp.concatenate([att * jax.nn.silu(g_att), c * jax.nn.silu(g_conv)], axis=-1)
    y = jnp.einsum('bte,ed->btd', mix, w_out)
    new_conv = u_pad[:, -(CONV_WIDTH - 1):]
    new_kv = jnp.stack([k, v], axis=2)
    return x + rms_norm(y, norm_post), new_conv, new_kv


def setup_inputs(seed: int = 0) -> dict:
    key = jax.random.key(seed)
    ks = jax.random.split(key, 16)
    nrm = jax.random.normal
    f = jnp.float32
    win_past = min(MAX_WINDOW, PAST_LEN)
    return {
        "x_prompt": nrm(ks[0], (BATCH, SEQ, D_MODEL), f),
        "x_sample": nrm(ks[1], (DEC_BATCH, DEC_SEQ, D_MODEL), f),
        "cache_conv": 0.5 * nrm(ks[2], (DEPTH, DEC_BATCH, CONV_WIDTH - 1, D_CONV), f),
        "cache_kv": nrm(ks[3], (DEPTH, DEC_BATCH, win_past, 2, N_HEADS, HEAD_DIM), f),
        "rel_bias": 0.5 * nrm(ks[4], (N_BUCKETS, N_HEADS), f),
        "norm_pre": 1.0 + 0.05 * nrm(ks[5], (DEPTH, D_MODEL), f),
        "w_in": nrm(ks[6], (DEPTH, D_MODEL, D_IN), f) * D_MODEL ** -0.5,
        "conv_dw_w": nrm(ks[7], (DEPTH, CONV_WIDTH, D_CONV), f) * CONV_WIDTH ** -0.5,
        "conv_dw_b": 0.02 * nrm(ks[8], (DEPTH, D_CONV), f),
        "conv_ln_g": 1.0 + 0.05 * nrm(ks[9], (DEPTH, D_CONV), f),
        "conv_ln_b": 0.02 * nrm(ks[10], (DEPTH, D_CONV), f),
        "conv_pw_w": nrm(ks[11], (DEPTH, D_CONV, D_CONV), f) * D_CONV ** -0.5,
        "conv_pw_b": 0.02 * nrm(ks[12], (DEPTH, D_CONV), f),
        "w_out": nrm(ks[13], (DEPTH, D_MIX, D_MODEL), f) * D_MIX ** -0.5,
        "norm_post": 1.0 + 0.05 * nrm(ks[14], (DEPTH, D_MODEL), f),
    }


def reference(x_prompt, x_sample, cache_conv, cache_kv, rel_bias, norm_pre, w_in, conv_dw_w,
              conv_dw_b, conv_ln_g, conv_ln_b, conv_pw_w, conv_pw_b, w_out, norm_post):
    xp, xs = x_prompt, x_sample
    win_prompt = min(MAX_WINDOW, xp.shape[1])
    conv_p, kv_p, conv_s, kv_s = [], [], [], []
    for l in range(DEPTH):
        lw = (norm_pre[l], w_in[l], conv_dw_w[l], conv_dw_b[l], conv_ln_g[l], conv_ln_b[l],
              conv_pw_w[l], conv_pw_b[l], w_out[l], norm_post[l])
        zero_prefix = jnp.zeros((xp.shape[0], CONV_WIDTH - 1, D_CONV), xp.dtype)
        xp, cp, kvp = mixer_sublayer(xp, zero_prefix,
                                     functools.partial(attend_prompt, rel_bias=rel_bias), *lw)
        conv_p.append(cp)
        kv_p.append(kvp[:, xp.shape[1] - win_prompt:])
        buf = cache_kv[l]
        xs, cs, kvs = mixer_sublayer(xs, cache_conv[l],
                                     functools.partial(attend_sample, kv_buf=buf, rel_bias=rel_bias), *lw)
        conv_s.append(cs)
        kv_s.append(jnp.concatenate([buf, kvs], axis=1)[:, kvs.shape[1]:])
    return (xp, xs, jnp.stack(conv_p), jnp.stack(kv_p), jnp.stack(conv_s), jnp.stack(kv_s))
```

```cpp
#include <hip/hip_runtime.h>
#include <hip/hip_cooperative_groups.h>
#include <cstdio>
#include <cstdint>
namespace cg = cooperative_groups;
#ifndef MK_N_LAUNCHES
#define MK_N_LAUNCHES 5
#endif
namespace pg8 {
#define PG8_LAS __attribute__((address_space(3)))
typedef unsigned short bf16_t;
typedef short bf16x8 __attribute__((ext_vector_type(8)));
typedef float f32x4 __attribute__((ext_vector_type(4)));
typedef unsigned u32x4 __attribute__((ext_vector_type(4)));
constexpr int BM = 256, BK = 64, HALF = 128, HTB = HALF * BK * 2  , STAGE_BYTES = 8 * HTB, NXCD = 8, WGM = 8;

__host__ __device__ __forceinline__ int lds_byte(int r, int c) { const int st = (r >> 4) * 2 + (c >> 5), rr = r & 15, cc = c & 31, ob = rr * 64 + cc * 2; return st * 1024 + (ob ^ (((ob >> 9) & 1) << 5)); }
__host__ __device__ __forceinline__ void stage_rc(int b, int& R, int& C) { const int st = b / 1024, sb = b % 1024, swz = sb ^ (((sb >> 9) & 1) << 5); R = (st >> 1) * 16 + swz / 64; C = (st & 1) * 32 + (swz % 64) / 2; }
__host__ __device__ __forceinline__ int perm32(int rho) { const int n = rho >> 4, i = rho & 15; return 8 * (i >> 2) + 4 * n + (i & 3); }

struct Unit { int pm, pn; };
struct Gemm { const bf16_t* A; const bf16_t* Bt; int M, N, K; };

struct StaticOrder {
    int nM, nN, nwg, G, c;
    __host__ __device__ void init(int M, int N, int G_, int c_) { nM = M / BM; nN = N / BM; nwg = nM * nN; G = G_; c = c_; }
    __host__ __device__ bool next(int i, Unit& u) const {
        const long L = (long)i * G + c; if (L >= nwg) return false;
        int wgid = (int)L; { const int q = nwg / NXCD, r = nwg % NXCD, xcd = wgid % NXCD, off = wgid / NXCD; wgid = (xcd < r ? xcd * (q + 1) : r * (q + 1) + (xcd - r) * q) + off; }
        const int nig = WGM * nN, gid = wgid / nig, fm = gid * WGM, gsz = (nM - fm) < WGM ? (nM - fm) : WGM;
        u.pm = fm + ((wgid % nig) % gsz); u.pn = (wgid % nig) / gsz; return true;
    }
    __device__ __forceinline__ void a_ready(const Unit&) const {}
    __device__ __forceinline__ void done(const Unit&) const {}
};
__device__ __forceinline__ unsigned cvt_pk_bf16(float lo, float hi) { unsigned r; asm volatile("v_cvt_pk_bf16_f32 %0, %1, %2" : "=v"(r) : "v"(lo), "v"(hi)); return r; }
template <class Epi, class Sched, bool STAMP = false>
__device__ __forceinline__ void gemm_phase(PG8_LAS unsigned char* lds, const Gemm g, const Sched& S, const Epi& E, unsigned long long* stamps) {
    const int tid = threadIdx.x, wid = __builtin_amdgcn_readfirstlane(tid >> 6), lane = tid & 63, wr = wid >> 2, wc = wid & 3, fr = lane & 15, fq = lane >> 4;
    const int K = g.K, nt = K / BK;
    int ts_lo = 0, ts_hi = 0, nts = 0; const unsigned long long rt_entry = STAMP ? (unsigned long long)wall_clock64() : 0ull;
#define PG8_STAMP() do { if (STAMP && wid == 0 && nts < 64) { const unsigned long long _c = (unsigned long long)clock64(); \
        ts_lo = (lane == nts) ? (int)(unsigned)_c : ts_lo; ts_hi = (lane == nts) ? (int)(unsigned)(_c >> 32) : ts_hi; ++nts; } } while (0)
    PG8_STAMP();
    unsigned voffA[2], voffB[2];
#pragma unroll
    for (int i = 0; i < 2; ++i) { int R, C; stage_rc(tid * 16 + i * 8192, R, C); const int Rb = Epi::PERM ? ((R & ~31) + perm32(R & 31)) : R;
        voffA[i] = (unsigned)(R * K + C) * 2u; voffB[i] = (unsigned)(Rb * K + C) * 2u; }
    const size_t kstep = (size_t)(BK * 2);
    const size_t hstep = (size_t)HALF * K * 2;
    const size_t tstep = 2 * hstep;
    const unsigned ldsw = (unsigned)wid * 1024u;
    const int aoff = lds_byte(wr * 64 + fr, fq * 8), boff = lds_byte(wc * 32 + fr, fq * 8);
#define PG8_SA(b, h) (((b) * 2 + (h)) * HTB)
#define PG8_SB(b, h) ((4 + (b) * 2 + (h)) * HTB)
#define PG8_STAGE(bufoff, gbase, voff) do { _Pragma("unroll") for (int _i = 0; _i < 2; ++_i) \
        __builtin_amdgcn_global_load_lds((const unsigned*)((const char*)(gbase) + (voff)[_i]), (PG8_LAS unsigned*)(lds + (bufoff) + ldsw + _i * 8192), 16, 0, 0); } while (0)
#define PG8_LDA(dst, b, h) do { _Pragma("unroll") for (int m = 0; m < 4; ++m) _Pragma("unroll") for (int k = 0; k < 2; ++k) dst[m][k] = *(const PG8_LAS bf16x8*)(lds + PG8_SA(b, h) + aoff + m * 2048 + k * 1024); } while (0)
#define PG8_LDB(dst, b, h) do { _Pragma("unroll") for (int n = 0; n < 2; ++n) _Pragma("unroll") for (int k = 0; k < 2; ++k) dst[n][k] = *(const PG8_LAS bf16x8*)(lds + PG8_SB(b, h) + boff + n * 2048 + k * 1024); } while (0)
#define PG8_MMA(ai, bj, At, Bt) do { __builtin_amdgcn_s_setprio(1); _Pragma("unroll") for (int m = 0; m < 4; ++m) _Pragma("unroll") for (int n = 0; n < 2; ++n) _Pragma("unroll") for (int k = 0; k < 2; ++k) \
        acc[ai][bj][m][n] = __builtin_amdgcn_mfma_f32_16x16x32_bf16(Bt[n][k], At[m][k], acc[ai][bj][m][n], 0, 0, 0); __builtin_amdgcn_s_setprio(0); } while (0)
#define PG8_WAIT_V(n) asm volatile("s_waitcnt vmcnt(" #n ")" ::: "memory")
#define PG8_WAIT_L(n) asm volatile("s_waitcnt lgkmcnt(" #n ")" ::: "memory")
#define PG8_BAR __builtin_amdgcn_s_barrier()
#define PG8_SCHED __builtin_amdgcn_sched_barrier(0)
    Unit cur, nxt; int ui = 0;
    if (!S.next(0, cur)) return;
    f32x4 acc[2][2][4][2];
#pragma unroll
    for (int a = 0; a < 2; ++a)
#pragma unroll
        for (int b = 0; b < 2; ++b)
#pragma unroll
            for (int m = 0; m < 4; ++m)
#pragma unroll
                for (int n = 0; n < 2; ++n) acc[a][b][m][n] = (f32x4){0.f, 0.f, 0.f, 0.f};
    bf16x8 At[4][2], B0[2][2], B1[2][2];
    const char* cA = (const char*)g.A + (size_t)cur.pm * tstep; const char* cB = (const char*)g.Bt + (size_t)cur.pn * tstep;
    S.a_ready(cur);
    PG8_STAGE(PG8_SB(0, 0), cB, voffB); PG8_STAGE(PG8_SA(0, 0), cA, voffA); PG8_STAGE(PG8_SB(0, 1), cB + hstep, voffB); PG8_STAGE(PG8_SA(0, 1), cA + hstep, voffA);
    if (wr == 1) PG8_BAR;
    PG8_WAIT_V(4); PG8_BAR;
    PG8_STAGE(PG8_SB(1, 0), cB + kstep, voffB); PG8_STAGE(PG8_SA(1, 0), cA + kstep, voffA); PG8_STAGE(PG8_SB(1, 1), cB + hstep + kstep, voffB);
    PG8_WAIT_V(6); PG8_BAR;
    PG8_STAMP();
    for (;;) {
        const bool has_next = S.next(ui + 1, nxt);
        const char* nA = has_next ? (const char*)g.A + (size_t)nxt.pm * tstep : cA; const char* nB = has_next ? (const char*)g.Bt + (size_t)nxt.pn * tstep : cB;
        for (int t = 0; t < nt; t += 2) {
            const bool last = (t == nt - 2);
            const char* a1 = cA + (size_t)(t + 1) * kstep;
            const char* a2 = last ? nA : cA + (size_t)(t + 2) * kstep; const char* b2 = last ? nB : cB + (size_t)(t + 2) * kstep;
            const char* a3 = a2 + kstep; const char* b3 = b2 + kstep;
            if (last && has_next) S.a_ready(nxt);
            PG8_LDB(B0, 0, 0); PG8_SCHED; PG8_LDA(At, 0, 0); PG8_STAGE(PG8_SA(1, 1), a1 + hstep, voffA);
            PG8_WAIT_L(8); PG8_BAR; PG8_WAIT_L(0); PG8_MMA(0, 0, At, B0); PG8_BAR; PG8_SCHED;
            PG8_LDB(B1, 0, 1); PG8_STAGE(PG8_SB(0, 0), b2, voffB);
            PG8_BAR; PG8_WAIT_L(0); PG8_MMA(0, 1, At, B1); PG8_BAR;
            PG8_LDA(At, 0, 1); PG8_STAGE(PG8_SA(0, 0), a2, voffA);
            PG8_BAR; PG8_WAIT_L(0); PG8_MMA(1, 0, At, B0); PG8_BAR; PG8_SCHED;
            PG8_STAGE(PG8_SB(0, 1), b2 + hstep, voffB);
            PG8_WAIT_V(6); PG8_BAR; PG8_MMA(1, 1, At, B1); PG8_BAR;
            PG8_LDB(B0, 1, 0); PG8_SCHED; PG8_LDA(At, 1, 0); PG8_STAGE(PG8_SA(0, 1), a2 + hstep, voffA);
            PG8_WAIT_L(8); PG8_BAR; PG8_WAIT_L(0); PG8_MMA(0, 0, At, B0); PG8_BAR; PG8_SCHED;
            PG8_LDB(B1, 1, 1); PG8_STAGE(PG8_SB(1, 0), b3, voffB);
            PG8_BAR; PG8_WAIT_L(0); PG8_MMA(0, 1, At, B1); PG8_BAR;
            PG8_LDA(At, 1, 1); PG8_STAGE(PG8_SA(1, 0), a3, voffA);
            PG8_BAR; PG8_WAIT_L(0); PG8_MMA(1, 0, At, B0); PG8_BAR; PG8_SCHED;
            PG8_STAGE(PG8_SB(1, 1), b3 + hstep, voffB);
            PG8_WAIT_V(6); PG8_BAR; PG8_MMA(1, 1, At, B1); PG8_BAR;
        }
        PG8_STAMP();
        if constexpr (!Epi::AFTER_DRAIN) { E(acc, cur, wr, wc, fr, fq); S.done(cur); }
        PG8_STAMP();
        if (!has_next) break;
#pragma unroll
        for (int a = 0; a < 2; ++a)
#pragma unroll
            for (int b = 0; b < 2; ++b)
#pragma unroll
                for (int m = 0; m < 4; ++m)
#pragma unroll
                    for (int n = 0; n < 2; ++n) acc[a][b][m][n] = (f32x4){0.f, 0.f, 0.f, 0.f};
        cur = nxt; cA = nA; cB = nB; ++ui;
    }
    PG8_WAIT_V(0);
    if (wr == 0) PG8_BAR;
    PG8_BAR;
    if constexpr (Epi::AFTER_DRAIN) { E.fused(acc, cur, wr, wc, fr, fq, lds, wid, lane); S.done(cur); }
    PG8_STAMP();
    if (STAMP && wid == 0) { stamps[lane] = lane < nts ? (((unsigned long long)(unsigned)ts_hi << 32) | (unsigned)ts_lo) : 0ull;
        if (lane == 62) stamps[62] = rt_entry; if (lane == 63) stamps[63] = (unsigned long long)wall_clock64(); }
#undef PG8_STAMP
#undef PG8_SA
#undef PG8_SB
#undef PG8_STAGE
#undef PG8_LDA
#undef PG8_LDB
#undef PG8_MMA
#undef PG8_WAIT_V
#undef PG8_WAIT_L
#undef PG8_BAR
#undef PG8_SCHED
}
}

#define LAS __attribute__((address_space(3)))
typedef unsigned short bf16_t;
typedef short bf16x8 __attribute__((ext_vector_type(8)));
typedef short s16x4 __attribute__((ext_vector_type(4)));
typedef float f32x4 __attribute__((ext_vector_type(4)));
typedef float f32x16 __attribute__((ext_vector_type(16)));
typedef unsigned u32x4 __attribute__((ext_vector_type(4)));
typedef unsigned u32x2 __attribute__((ext_vector_type(2)));
using pg8::cvt_pk_bf16;

constexpr int DM = 2048, NPR = 8192, NSM = 128, MROWS = 8320, MPAD = 8448;
constexpr int DIN = 7680, SEQ = 2048, NBP = 4, NBS = 32, DT = 4, NH = 12;
constexpr int LDZ = 6144;
constexpr float EPS = 1e-6f;
constexpr float LOG2E = 1.4426950408889634f;
constexpr float QSCALE = 0.08838834764831845f * 1.4426950408889634f;
constexpr float NEGBIG = -1e30f;
constexpr size_t O_YP = 0, O_YS = 16777216, O_CP = 17039360, O_KVP = 17100800, O_CS = 42266624, O_KVS = 42758144;
constexpr size_t MiB = 1u << 20;
constexpr size_t WS_CTL = 0, CTL_BYTES = 4096;
constexpr size_t WS_WIN = 1 * MiB, WS_WOUT = 32 * MiB, WS_WPW = 40 * MiB, WS_TAB = 41 * MiB, WS_H = 42 * MiB, WS_Z = 76 * MiB, WS_GC = 176 * MiB;
constexpr size_t WS_UPP = 186 * MiB, WS_UPS = 195 * MiB, WS_MIX = 198 * MiB, WS_Y = 232 * MiB, WS_END = 300 * MiB;
constexpr int TAB_NEG = 384, TAB_N = 2688;
constexpr int LDS_TAB = 131072, LDS_AL = LDS_TAB + TAB_N * 4, LDS_MISC = LDS_AL + 2048, LDS_BYTES = 147456;
static_assert(LDS_MISC + 256 <= LDS_BYTES, "LDS map");

struct Params { const float* in[15]; float* out; unsigned char* ws; int ph_lo, ph_hi; };

template <class T> __device__ __forceinline__ T* launder(T* q) { asm volatile("" : "+s"(q)); return q; }
__device__ __forceinline__ float bf2f(bf16_t v) { return __uint_as_float(((unsigned)v) << 16); }
__device__ __forceinline__ bf16_t f2bf(float f) { unsigned u = __float_as_uint(f); return (bf16_t)((u + 0x7fffu + ((u >> 16) & 1u)) >> 16); }
__device__ __forceinline__ float wave_sum(float v) {
#pragma unroll
    for (int o = 1; o < 64; o <<= 1) v += __shfl_xor(v, o);
    return v;
}
__device__ __forceinline__ float fast_sigmoid(float x) { return __builtin_amdgcn_rcpf(1.0f + __builtin_amdgcn_exp2f(-x * LOG2E)); }
__device__ __forceinline__ float silu_f(float x) { return x * fast_sigmoid(x); }

__device__ __forceinline__ void p0_transpose_item(const float* __restrict__ W, int K, int N, bf16_t* __restrict__ WT, int k0, int nsrc0, int ndst0, LAS float* scr, int lane) {
#pragma unroll 8
    for (int i = 0; i < 32; ++i) { const int kk = 2 * i + (lane >> 5); scr[kk * 33 + (lane & 31)] = W[(size_t)(k0 + kk) * N + nsrc0 + (lane & 31)]; }
    asm volatile("s_waitcnt lgkmcnt(0)" ::: "memory");
    const int c = lane & 7;
#pragma unroll
    for (int j = 0; j < 4; ++j) { const int n = (lane >> 3) + 8 * j; const LAS float* s = scr + (8 * c) * 33 + n;
        u32x4 o; o.x = cvt_pk_bf16(s[0 * 33], s[1 * 33]); o.y = cvt_pk_bf16(s[2 * 33], s[3 * 33]); o.z = cvt_pk_bf16(s[4 * 33], s[5 * 33]); o.w = cvt_pk_bf16(s[6 * 33], s[7 * 33]);
        *(u32x4*)(WT + (size_t)(ndst0 + n) * K + k0 + 8 * c) = o; }
    asm volatile("s_waitcnt lgkmcnt(0)" ::: "memory");
}
__device__ __forceinline__ int win_src_col(int nv) {
    if (nv < 6144 || nv >= 7168) return nv;
    const int g = (nv - 6144) >> 8, r = (nv - 6144) & 255;
    return r < 128 ? 6144 + 128 * g + r : 6656 + 128 * g + (r - 128);
}
__device__ __forceinline__ int rel_bucket(int dist) {
    if (dist < 16) return dist;
    const double d = (double)dist;
    int lb = 16 + (int)(log(d / 16.0) / log(128.0) * 16.0);
    return lb < 31 ? lb : 31;
}
__device__ __forceinline__ void p0_prologue(const Params& p, LAS unsigned char* lds) {
    const int tid = threadIdx.x, lane = tid & 63, wave = tid >> 6;
    const int gw = blockIdx.x * 8 + wave, NGW = gridDim.x * 8;
    const size_t gt = (size_t)blockIdx.x * 512 + tid, NGT = (size_t)gridDim.x * 512;
    unsigned char* ws = p.ws;
    {
        LAS float* scr = (LAS float*)(lds + wave * 16384);
        constexpr int I_IN = 32 * 240, I_OUT = 32 * 64, I_PW = 8 * 16;
        bf16_t* WinT = (bf16_t*)(ws + WS_WIN); bf16_t* WoutT = (bf16_t*)(ws + WS_WOUT); bf16_t* WpwT = (bf16_t*)(ws + WS_WPW);
        for (int it = gw; it < I_IN + I_OUT + I_PW; it += NGW) {
            int r = it;
            if (r < I_IN) { const int kb = r / 240, nb = r % 240; p0_transpose_item(p.in[6], 2048, DIN, WinT, 64 * kb, win_src_col(32 * nb), 32 * nb, scr, lane); continue; } r -= I_IN;
            if (r < I_OUT) { const int kb = r / 64, nb = r % 64; p0_transpose_item(p.in[13], 2048, 2048, WoutT, 64 * kb, 32 * nb, 32 * nb, scr, lane); continue; } r -= I_OUT;
            { const int kb = r / 16, nb = r % 16; p0_transpose_item(p.in[11], 512, 512, WpwT, 64 * kb, 32 * nb, 32 * nb, scr, lane); }
        }
    }
    {
        bf16_t* H = (bf16_t*)(ws + WS_H);
        const f32x4* gp = (const f32x4*)p.in[5] + lane;
        for (int m = gw; m < MPAD; m += NGW) {
            unsigned long long* o8 = (unsigned long long*)(H + (size_t)m * DM) + lane;
            if (m < MROWS) {
                const float* xrow = m < NPR ? p.in[0] + (size_t)m * DM : p.in[1] + (size_t)(m - NPR) * DM;
                const f32x4* xr = (const f32x4*)xrow + lane;
                f32x4 v[8]; float s = 0.f;
#pragma unroll
                for (int j = 0; j < 8; ++j) { v[j] = xr[64 * j]; s += (v[j].x * v[j].x + v[j].y * v[j].y) + (v[j].z * v[j].z + v[j].w * v[j].w); }
                const float rstd = 1.0f / sqrtf(wave_sum(s) * (1.f / DM) + EPS);
#pragma unroll
                for (int j = 0; j < 8; ++j) { const f32x4 g = gp[64 * j];
                    o8[64 * j] = (unsigned long long)cvt_pk_bf16(v[j].x * rstd * g.x, v[j].y * rstd * g.y) | ((unsigned long long)cvt_pk_bf16(v[j].z * rstd * g.z, v[j].w * rstd * g.w) << 32); }
            } else {
#pragma unroll
                for (int j = 0; j < 8; ++j) o8[64 * j] = 0ull;
            }
        }
    }
    {
        bf16_t* UPP = (bf16_t*)(ws + WS_UPP); bf16_t* UPS = (bf16_t*)(ws + WS_UPS);
        for (size_t i = gt; i < (size_t)NBP * 30 * 512; i += NGT) { const size_t b = i / (30 * 512), r = i % (30 * 512); UPP[b * 2078 * 512 + r] = 0; }
        const float* cc = p.in[2];
        for (size_t i = gt; i < (size_t)NBS * 30 * 512; i += NGT) { const size_t b = i / (30 * 512), r = i % (30 * 512); const float v = cc[i];
            UPS[b * 34 * 512 + r] = f2bf(v);
            if (r >= 4 * 512) p.out[O_CS + b * 30 * 512 + (r - 4 * 512)] = v; }
    }
    {
        float* tabg = (float*)(ws + WS_TAB); const float* rb = p.in[4];
        for (size_t i = gt; i < (size_t)NH * TAB_N; i += NGT) {
            const int h = (int)(i / TAB_N), dist = (int)(i % TAB_N) - TAB_NEG; float v = NEGBIG;
            if (dist >= 0 && dist <= 2048) {
                const int mult = (dist <= 128 ? 1 : 0) + (((dist & 3) == 0 && dist <= 512) ? 1 : 0) + ((dist & 15) == 0 ? 1 : 0);
                if (mult > 0) v = rb[rel_bucket(dist) * NH + h] * LOG2E + (mult == 1 ? 0.f : (mult == 2 ? 1.f : 1.5849625007211562f));
            }
            tabg[i] = v;
        }
    }
    {
        const f32x4* src = (const f32x4*)p.in[3]; f32x4* dst = (f32x4*)(p.out + O_KVS);
        constexpr size_t PERB = (size_t)2048 * 768, CNT = (size_t)2044 * 768, TOT = (size_t)NBS * CNT;
        for (size_t i = gt; i < TOT; i += 4 * NGT) {
            f32x4 v[4];
#pragma unroll
            for (int u = 0; u < 4; ++u) { const size_t k = i + u * NGT; if (k < TOT) { const size_t b = k / CNT, r = k % CNT; v[u] = __builtin_nontemporal_load(src + b * PERB + 4 * 768 + r); } }
#pragma unroll
            for (int u = 0; u < 4; ++u) { const size_t k = i + u * NGT; if (k < TOT) { const size_t b = k / CNT, r = k % CNT; __builtin_nontemporal_store(v[u], dst + b * PERB + r); } }
        }
    }
}

struct EpiInProj {
    static constexpr bool PERM = true, AFTER_DRAIN = false;
    bf16_t* Z; bf16_t* GC; bf16_t* UPP; bf16_t* UPS; float* out;
    __device__ __forceinline__ void operator()(const f32x4 (&acc)[2][2][4][2], const pg8::Unit& u, int wr, int wc, int fr, int fq) const {
        const int pn = u.pn;
        const int row0 = u.pm * 256 + wr * 64 + fr, cw = wc * 32 + 8 * fq;
        if (pn < 24) {
            const int kind = pn < 6 ? 0 : (pn < 18 ? 1 : 2);
#pragma unroll
            for (int ai = 0; ai < 2; ++ai)
#pragma unroll
                for (int m = 0; m < 4; ++m) {
                    const int r = row0 + ai * 128 + m * 16;
                    if (r >= MROWS) continue;
                    bf16_t* zrow = Z + (size_t)r * LDZ + pn * 256 + cw;
                    float* kvrow = nullptr;
                    if (kind == 1) { const size_t orow = r < NPR ? (size_t)r : (size_t)((r - NPR) >> 2) * 2048 + 2044 + ((r - NPR) & 3);
                        kvrow = out + (r < NPR ? O_KVP : O_KVS) + orow * 3072 + (pn * 256 - 1536) + cw; }
#pragma unroll
                    for (int bj = 0; bj < 2; ++bj) { f32x4 v0 = acc[ai][bj][m][0], v1 = acc[ai][bj][m][1];
                        if (kind == 1) { *(f32x4*)(kvrow + bj * 128) = v0; *(f32x4*)(kvrow + bj * 128 + 4) = v1; }
                        if (kind == 0) { v0 *= QSCALE; v1 *= QSCALE; }
                        if (kind == 2) {
#pragma unroll
                            for (int j = 0; j < 4; ++j) { v0[j] = silu_f(v0[j]); v1[j] = silu_f(v1[j]); } }
                        u32x4 w; w.x = cvt_pk_bf16(v0[0], v0[1]); w.y = cvt_pk_bf16(v0[2], v0[3]); w.z = cvt_pk_bf16(v1[0], v1[1]); w.w = cvt_pk_bf16(v1[2], v1[3]);
                        *(u32x4*)(zrow + bj * 128) = w; }
                }
        } else if (pn < 28) {
            const int cu = (pn - 24) * 128 + cw;
#pragma unroll
            for (int ai = 0; ai < 2; ++ai)
#pragma unroll
                for (int m = 0; m < 4; ++m) {
                    const int r = row0 + ai * 128 + m * 16;
                    if (r >= MROWS) continue;
                    f32x4 a0 = acc[ai][0][m][0], a1 = acc[ai][0][m][1]; const f32x4 b0 = acc[ai][1][m][0], b1 = acc[ai][1][m][1];
#pragma unroll
                    for (int j = 0; j < 4; ++j) { a0[j] *= fast_sigmoid(b0[j]); a1[j] *= fast_sigmoid(b1[j]); }
                    u32x4 w; w.x = cvt_pk_bf16(a0[0], a0[1]); w.y = cvt_pk_bf16(a0[2], a0[3]); w.z = cvt_pk_bf16(a1[0], a1[1]); w.w = cvt_pk_bf16(a1[2], a1[3]);
                    if (r < NPR) { const int b = r >> 11, t = r & 2047;
                        *(u32x4*)(UPP + ((size_t)b * 2078 + 30 + t) * 512 + cu) = w;
                        if (t >= 2018) { float* o = out + O_CP + ((size_t)b * 30 + (t - 2018)) * 512 + cu; *(f32x4*)o = a0; *(f32x4*)(o + 4) = a1; } }
                    else { const int b = (r - NPR) >> 2, j = (r - NPR) & 3;
                        *(u32x4*)(UPS + ((size_t)b * 34 + 30 + j) * 512 + cu) = w;
                        float* o = out + O_CS + ((size_t)b * 30 + 26 + j) * 512 + cu; *(f32x4*)o = a0; *(f32x4*)(o + 4) = a1; }
                }
        } else {
#pragma unroll
            for (int ai = 0; ai < 2; ++ai)
#pragma unroll
                for (int m = 0; m < 4; ++m) {
                    const int r = row0 + ai * 128 + m * 16;
                    if (r >= MROWS) continue;
                    bf16_t* grow = GC + (size_t)r * 512 + (pn - 28) * 256 + cw;
#pragma unroll
                    for (int bj = 0; bj < 2; ++bj) { f32x4 v0 = acc[ai][bj][m][0], v1 = acc[ai][bj][m][1];
#pragma unroll
                        for (int j = 0; j < 4; ++j) { v0[j] = silu_f(v0[j]); v1[j] = silu_f(v1[j]); }
                        u32x4 w; w.x = cvt_pk_bf16(v0[0], v0[1]); w.y = cvt_pk_bf16(v0[2], v0[3]); w.z = cvt_pk_bf16(v1[0], v1[1]); w.w = cvt_pk_bf16(v1[2], v1[3]);
                        *(u32x4*)(grow + bj * 128) = w; }
                }
        }
    }
};
struct EpiOutProj {
    static constexpr bool PERM = false, AFTER_DRAIN = false;
    float* C;
    __device__ __forceinline__ void operator()(const f32x4 (&acc)[2][2][4][2], const pg8::Unit& u, int wr, int wc, int fr, int fq) const {
        const int row0 = u.pm * 256 + wr * 64 + fr, col0 = u.pn * 256 + wc * 32 + 4 * fq;
#pragma unroll
        for (int ai = 0; ai < 2; ++ai)
#pragma unroll
            for (int m = 0; m < 4; ++m) { float* rowp = C + (size_t)(row0 + ai * 128 + m * 16) * DM + col0;
#pragma unroll
                for (int bj = 0; bj < 2; ++bj)
#pragma unroll
                    for (int n = 0; n < 2; ++n) *(f32x4*)(rowp + bj * 128 + n * 16) = acc[ai][bj][m][n]; }
    }
};

#define KSWZ(row, colB) ((row) * 256 + ((colB) ^ (((row) & 7) << 4)))
__device__ __forceinline__ int crow(int r, int hi) { return (r & 3) + 8 * (r >> 2) + 4 * hi; }
__device__ __forceinline__ int v_st(int k, int c) { const int kk = (k & ~0xC) | ((k & 4) << 1) | ((k & 8) >> 1); return ((kk >> 3) * 4 + (c >> 5)) * 512 + ((kk & 7) * 32 + (c & 31)) * 2; }
__device__ __forceinline__ int v_rd_base(int lane) { return ((lane & 3) << 3) | (((lane >> 2) & 3) << 6) | (((lane >> 4) & 1) << 5) | (((lane >> 5) & 1) << 8); }
constexpr int v_rd_off(int d0, int ks, int half) { return d0 * 512 + ks * 4096 + half * 2048; }
template <int OFF> __device__ __forceinline__ s16x4 tr_read(int vb) {
    s16x4 r; asm volatile("ds_read_b64_tr_b16 %0, %1 offset:%2" : "=&v"(r) : "v"(vb), "i"(OFF) : "memory"); return r;
}
template <int D0> __device__ __forceinline__ void pv_one(f32x16& od, int vb, bf16x8 pa0, bf16x8 pa1) {
    const s16x4 l0 = tr_read<v_rd_off(D0, 0, 0)>(vb), h0 = tr_read<v_rd_off(D0, 0, 1)>(vb), l1 = tr_read<v_rd_off(D0, 1, 0)>(vb), h1 = tr_read<v_rd_off(D0, 1, 1)>(vb);
    asm volatile("s_waitcnt lgkmcnt(0)" ::: "memory"); __builtin_amdgcn_sched_barrier(0);
#define PKV(L, H) (bf16x8){L[0], L[1], L[2], L[3], H[0], H[1], H[2], H[3]}
    od = __builtin_amdgcn_mfma_f32_32x32x16_bf16(pa0, PKV(l0, h0), od, 0, 0, 0);
    od = __builtin_amdgcn_mfma_f32_32x32x16_bf16(pa1, PKV(l1, h1), od, 0, 0, 0);
#undef PKV
}
constexpr float ATT_THR = 8.0f;
__device__ __forceinline__ void attn_tile(const LAS unsigned char* Kt, int vb, const bf16x8 (&qr)[8], const LAS float* tabp, f32x16 (&o)[4], float& m_reg, float& l_reg,
                                          LAS float* al_l, int r32, int hi) {
    f32x16 p = {};
#pragma unroll
    for (int d0 = 0; d0 < 8; ++d0) { const int cb = (d0 * 16 + hi * 8) * 2;
        const bf16x8 kf = *(const LAS bf16x8*)(Kt + KSWZ(r32, cb));
        p = __builtin_amdgcn_mfma_f32_32x32x16_bf16(kf, qr[d0], p, 0, 0, 0); }
#pragma unroll
    for (int r = 0; r < 16; ++r) p[r] += tabp[-(4 * (r & 3) + 32 * (r >> 2))];
    float pmax = p[0];
#pragma unroll
    for (int r = 1; r < 16; ++r) pmax = fmaxf(pmax, p[r]);
    pmax = fmaxf(pmax, __shfl_xor(pmax, 32));
    float mn, alpha;
    if (__all(pmax - m_reg <= ATT_THR)) { mn = m_reg; alpha = 1.f; }
    else { mn = fmaxf(m_reg, pmax); alpha = __builtin_amdgcn_exp2f(m_reg - mn); m_reg = mn; }
    float ps = 0.f;
#pragma unroll
    for (int r = 0; r < 16; ++r) { p[r] = __builtin_amdgcn_exp2f(p[r] - mn); ps += p[r]; }
    ps += __shfl_xor(ps, 32);
    l_reg = l_reg * alpha + ps;
    bf16x8 pa0, pa1;
#define PK4(P, BASE, OUT) do { unsigned a0 = cvt_pk_bf16(P[BASE + 0], P[BASE + 1]), a1 = cvt_pk_bf16(P[BASE + 2], P[BASE + 3]);   \
    unsigned b0 = cvt_pk_bf16(P[BASE + 4], P[BASE + 5]), b1 = cvt_pk_bf16(P[BASE + 6], P[BASE + 7]);                              \
    auto r0 = __builtin_amdgcn_permlane32_swap(a0, b0, false, false); auto r1 = __builtin_amdgcn_permlane32_swap(a1, b1, false, false); \
    u32x4 w = {r0[0], r1[0], r0[1], r1[1]}; OUT = *reinterpret_cast<bf16x8*>(&w); } while (0)
    PK4(p, 0, pa0); PK4(p, 8, pa1);
#undef PK4
    if (__any(alpha < 1.f)) {
        if (hi == 0) al_l[r32] = alpha;
        asm volatile("s_waitcnt lgkmcnt(0)" ::: "memory");
#pragma unroll
        for (int r = 0; r < 16; ++r) { const float a = al_l[crow(r, hi)];
#pragma unroll
            for (int d = 0; d < 4; ++d) o[d][r] *= a; }
    }
    pv_one<0>(o[0], vb, pa0, pa1); pv_one<1>(o[1], vb, pa0, pa1); pv_one<2>(o[2], vb, pa0, pa1); pv_one<3>(o[3], vb, pa0, pa1);
}

__device__ __forceinline__ void attn_prompt_item(const Params& p, LAS unsigned char* lds, int b, int h, int qt) {
    int tid = threadIdx.x; asm volatile("" : "+v"(tid));
    const int wid = __builtin_amdgcn_readfirstlane(tid >> 6), lane = tid & 63, r32 = lane & 31, hi = lane >> 5;
    unsigned char* const wsl = launder(p.ws);
    const bf16_t* __restrict__ Z = (const bf16_t*)(wsl + WS_Z);
    bf16_t* __restrict__ MIX = (bf16_t*)(wsl + WS_MIX);
    const int t0 = qt * 256;
    const size_t rowbase = (size_t)b * SEQ;
    LAS float* tab = (LAS float*)(lds + LDS_TAB);
    LAS float* al_l = (LAS float*)(lds + LDS_AL) + wid * 64;
    { const float* tg = (const float*)(wsl + WS_TAB) + h * TAB_N; for (int i = tid; i < TAB_N; i += 512) tab[i] = tg[i]; }
    bf16x8 qr[8];
    { const bf16_t* qp = Z + (rowbase + t0 + 8 * r32 + wid) * LDZ + h * 128 + hi * 8;
#pragma unroll
      for (int d0 = 0; d0 < 8; ++d0) qr[d0] = *(const bf16x8*)(qp + 16 * d0); }
    size_t kofs, vofs;
    { const int rowK = 4 * wid + (lane >> 4), colB = (16 * (lane & 15)) ^ ((rowK & 7) << 4);
      kofs = (size_t)(4 * rowK) * LDZ + 1536 + h * 128 + (colB >> 1);
      const int st = 2 * wid + (lane >> 5), kk = ((st >> 2) << 3) | ((lane & 31) >> 2), k = (kk & ~0xC) | ((kk & 4) << 1) | ((kk & 8) >> 1), cc = 32 * (st & 3) + 8 * (lane & 3);
      vofs = (size_t)(4 * k) * LDZ + 3072 + h * 128 + cc; }
    const bf16_t* zb = Z + rowbase * LDZ;
#define STAGE(c, bsel) do { const bf16_t* g_ = zb + (size_t)(c) * 128 * LDZ; LAS unsigned char* d_ = lds + (bsel) * 65536 + wid * 1024; \
        _Pragma("unroll") for (int g2 = 0; g2 < 4; ++g2) { \
            __builtin_amdgcn_global_load_lds((const unsigned*)(g_ + kofs + (size_t)g2 * LDZ), (LAS unsigned*)(d_ + g2 * 8192), 16, 0, 0); \
            __builtin_amdgcn_global_load_lds((const unsigned*)(g_ + vofs + (size_t)g2 * LDZ), (LAS unsigned*)(d_ + 32768 + g2 * 8192), 16, 0, 0); } } while (0)
    f32x16 o[4] = {}; float m_reg = -1e20f, l_reg = 0.f;
    const int nch = 2 * qt + 2;
    STAGE(0, 0);
    asm volatile("s_waitcnt vmcnt(0)" ::: "memory");
    __syncthreads();
    const int vrb = v_rd_base(lane);
    for (int c = 0; c < nch; ++c) {
        if (c + 1 < nch) STAGE(c + 1, (c + 1) & 1);
        const int bsel = c & 1, p0 = c * 128;
        const bool is_near = (c >= 2 * qt - 1);
        const int tib0 = t0 + 8 * r32 + wid - p0 + TAB_NEG - 16 * hi;
        const LAS unsigned char* kbuf = lds + bsel * 65536;
        const int vbuf = (int)(unsigned)(size_t)(lds + bsel * 65536 + 32768) + vrb;
        if (is_near) {
#pragma unroll 1
            for (int g = 0; g < 4; ++g) attn_tile(kbuf + g * 8192, vbuf + g * 8192, qr, tab + (tib0 - g), o, m_reg, l_reg, al_l, r32, hi);
        } else {
            const int g = wid & 3;
            attn_tile(kbuf + g * 8192, vbuf + g * 8192, qr, tab + (tib0 - g), o, m_reg, l_reg, al_l, r32, hi);
        }
        asm volatile("s_waitcnt vmcnt(0)" ::: "memory");
        __syncthreads();
    }
#undef STAGE
    if (hi == 0) al_l[32 + r32] = l_reg;
    asm volatile("s_waitcnt lgkmcnt(0)" ::: "memory");
#pragma unroll
    for (int r = 0; r < 16; ++r) { const int qi = crow(r, hi); const float rl = __builtin_amdgcn_rcpf(al_l[32 + qi]);
        const size_t m = rowbase + t0 + 8 * qi + wid;
        const bf16_t* gp = Z + m * LDZ + 4608 + h * 128 + r32; bf16_t* mp = MIX + m * DM + h * 128 + r32;
#pragma unroll
        for (int d0 = 0; d0 < 4; ++d0) mp[32 * d0] = f2bf(o[d0][r] * rl * bf2f(gp[32 * d0]));
        asm volatile("" ::: "memory"); }
    __syncthreads();
}

__device__ __forceinline__ void attn_sample_item(const Params& p, LAS unsigned char* lds, int b, int h) {
    int tid = threadIdx.x; asm volatile("" : "+v"(tid));
    const int hw = tid >> 5, l32 = tid & 31, wid = tid >> 6, lane = tid & 63;
    unsigned char* const wsl = launder(p.ws); float* const outl = launder(p.out); const float* const ckv = launder(p.in[3]);
    const bf16_t* __restrict__ Z = (const bf16_t*)(wsl + WS_Z);
    bf16_t* __restrict__ MIX = (bf16_t*)(wsl + WS_MIX);
    LAS float* sc = (LAS float*)lds;
    LAS float* red = (LAS float*)(lds + 16384);
    LAS float* lsum = (LAS float*)(lds + 16384 + 32768);
    LAS float* tab = (LAS float*)(lds + LDS_TAB);
    { const float* tg = (const float*)(wsl + WS_TAB) + h * TAB_N; for (int i = tid; i < TAB_N; i += 512) tab[i] = tg[i]; }
    float q[4][4];
#pragma unroll
    for (int j = 0; j < 4; ++j) { const u32x2 w = *(const u32x2*)(Z + (size_t)(NPR + b * 4 + j) * LDZ + h * 128 + 4 * l32);
        q[j][0] = __uint_as_float(w.x << 16); q[j][1] = __uint_as_float(w.x & 0xffff0000u); q[j][2] = __uint_as_float(w.y << 16); q[j][3] = __uint_as_float(w.y & 0xffff0000u); }
    const float* __restrict__ ck = ckv + (size_t)b * 2048 * 3072 + h * 128 + 4 * l32;
    const float* __restrict__ nk = outl + O_KVS + (size_t)b * 2048 * 3072 + h * 128 + 4 * l32;
    __syncthreads();
#pragma unroll 4
    for (int n = hw; n < 900; n += 16) {
        const int s = n < 384 ? 16 * (n >> 2) + (n & 3) : 1536 + (n - 384);
        const f32x4 kv = *(const f32x4*)(s < 2048 ? ck + (size_t)s * 3072 : nk + (size_t)(s - 4) * 3072);
        float d0 = q[0][0] * kv.x + q[0][1] * kv.y + q[0][2] * kv.z + q[0][3] * kv.w;
        float d1 = q[1][0] * kv.x + q[1][1] * kv.y + q[1][2] * kv.z + q[1][3] * kv.w;
        float d2 = q[2][0] * kv.x + q[2][1] * kv.y + q[2][2] * kv.z + q[2][3] * kv.w;
        float d3 = q[3][0] * kv.x + q[3][1] * kv.y + q[3][2] * kv.z + q[3][3] * kv.w;
#pragma unroll
        for (int o = 16; o >= 1; o >>= 1) { d0 += __shfl_xor(d0, o); d1 += __shfl_xor(d1, o); d2 += __shfl_xor(d2, o); d3 += __shfl_xor(d3, o); }
        if (l32 < 4) { const float d = l32 == 0 ? d0 : (l32 == 1 ? d1 : (l32 == 2 ? d2 : d3)); sc[n * 4 + l32] = d + tab[2048 + l32 - s + TAB_NEG]; }
    }
    __syncthreads();
    if (wid < 4) {
        float mx = NEGBIG;
        for (int n = lane; n < 900; n += 64) mx = fmaxf(mx, sc[n * 4 + wid]);
#pragma unroll
        for (int o = 1; o < 64; o <<= 1) mx = fmaxf(mx, __shfl_xor(mx, o));
        float sm = 0.f;
        for (int n = lane; n < 900; n += 64) { const float e = __builtin_amdgcn_exp2f(sc[n * 4 + wid] - mx); sc[n * 4 + wid] = e; sm += e; }
        sm = wave_sum(sm);
        if (lane == 0) lsum[wid] = sm;
    }
    __syncthreads();
    float o[4][4] = {};
#pragma unroll 4
    for (int n = hw; n < 900; n += 16) {
        const int s = n < 384 ? 16 * (n >> 2) + (n & 3) : 1536 + (n - 384);
        const f32x4 vv = *(const f32x4*)((s < 2048 ? ck + (size_t)s * 3072 : nk + (size_t)(s - 4) * 3072) + 1536);
        const f32x4 pp = *(const LAS f32x4*)(sc + n * 4);
#pragma unroll
        for (int j = 0; j < 4; ++j) { o[j][0] += pp[j] * vv.x; o[j][1] += pp[j] * vv.y; o[j][2] += pp[j] * vv.z; o[j][3] += pp[j] * vv.w; }
    }
#pragma unroll
    for (int j = 0; j < 4; ++j) *(LAS f32x4*)(red + (hw * 4 + j) * 128 + 4 * l32) = (f32x4){o[j][0], o[j][1], o[j][2], o[j][3]};
    __syncthreads();
    { const int j = tid >> 7, dh = tid & 127; float s = 0.f;
#pragma unroll
      for (int k = 0; k < 16; ++k) s += red[(k * 4 + j) * 128 + dh];
      const size_t m = (size_t)NPR + b * 4 + j;
      MIX[m * DM + h * 128 + dh] = f2bf(s / lsum[j] * bf2f(Z[m * LDZ + 4608 + h * 128 + dh])); }
    __syncthreads();
}

__device__ __forceinline__ void conv_item(const Params& p, LAS unsigned char* lds, int tile) {
    int tid = threadIdx.x; asm volatile("" : "+v"(tid));
    const int wid = __builtin_amdgcn_readfirstlane(tid >> 6), lane = tid & 63, r32 = lane & 31, hi = lane >> 5;
    LAS float* cbuf = (LAS float*)lds;
    unsigned char* const wsl = launder(p.ws);
    const float* const dww = launder(p.in[7]); const float* const dwb = launder(p.in[8]); const float* const lng = launder(p.in[9]); const float* const lnb = launder(p.in[10]); const float* const pwb = launder(p.in[12]);
    const bf16_t* __restrict__ GC = (const bf16_t*)(wsl + WS_GC);
    bf16_t* __restrict__ MIX = (bf16_t*)(wsl + WS_MIX);
    size_t mbase;
    {
        const int c = tid;
        float w[31];
#pragma unroll
        for (int j = 0; j < 31; ++j) w[j] = dww[j * 512 + c];
        const float bias = dwb[c];
        if (tile < 128) {
            const int b = tile >> 5, t0 = (tile & 31) * 64; mbase = (size_t)b * SEQ + t0;
            const bf16_t* __restrict__ up = (const bf16_t*)(wsl + WS_UPP) + ((size_t)b * 2078 + t0) * 512 + c;
#pragma unroll 1
            for (int g = 0; g < 8; ++g) {
                float win[38];
#pragma unroll
                for (int i = 0; i < 38; ++i) win[i] = bf2f(up[(size_t)(8 * g + i) * 512]);
#pragma unroll
                for (int o = 0; o < 8; ++o) { float a = bias;
#pragma unroll
                    for (int j = 0; j < 31; ++j) a += w[j] * win[o + j];
                    cbuf[(8 * g + o) * 512 + c] = a; }
            }
        } else {
            const int bb0 = (tile - 128) * 16; mbase = (size_t)NPR + bb0 * 4;
            const bf16_t* __restrict__ up = (const bf16_t*)(wsl + WS_UPS) + (size_t)bb0 * 34 * 512 + c;
#pragma unroll 1
            for (int bb = 0; bb < 16; ++bb) {
                float win[34];
#pragma unroll
                for (int i = 0; i < 34; ++i) win[i] = bf2f(up[(size_t)(bb * 34 + i) * 512]);
#pragma unroll
                for (int o = 0; o < 4; ++o) { float a = bias;
#pragma unroll
                    for (int j = 0; j < 31; ++j) a += w[j] * win[o + j];
                    cbuf[(bb * 4 + o) * 512 + c] = a; }
            }
        }
    }
    __syncthreads();
    {
        const f32x4 g0 = *(const f32x4*)(lng + 8 * lane), g1 = *(const f32x4*)(lng + 8 * lane + 4);
        const f32x4 b0 = *(const f32x4*)(lnb + 8 * lane), b1 = *(const f32x4*)(lnb + 8 * lane + 4);
#pragma unroll 1
        for (int tk = 0; tk < 8; ++tk) {
            const int row = 8 * wid + tk;
            f32x4 x0 = *(const LAS f32x4*)(cbuf + row * 512 + 8 * lane), x1 = *(const LAS f32x4*)(cbuf + row * 512 + 8 * lane + 4);
            const float mu = wave_sum((x0.x + x0.y) + (x0.z + x0.w) + (x1.x + x1.y) + (x1.z + x1.w)) * (1.f / 512.f);
            x0 = x0 - mu; x1 = x1 - mu;
            const float var = wave_sum((x0.x * x0.x + x0.y * x0.y) + (x0.z * x0.z + x0.w * x0.w) + (x1.x * x1.x + x1.y * x1.y) + (x1.z * x1.z + x1.w * x1.w)) * (1.f / 512.f);
            const float rstd = 1.0f / sqrtf(var + EPS);
            x0 = x0 * rstd * g0 + b0; x1 = x1 * rstd * g1 + b1;
#pragma unroll
            for (int j = 0; j < 4; ++j) { x0[j] = silu_f(x0[j]); x1[j] = silu_f(x1[j]); }
            u32x4 wv; wv.x = cvt_pk_bf16(x0[0], x0[1]); wv.y = cvt_pk_bf16(x0[2], x0[3]); wv.z = cvt_pk_bf16(x1[0], x1[1]); wv.w = cvt_pk_bf16(x1[2], x1[3]);
            *(LAS u32x4*)((LAS unsigned char*)cbuf + row * 2048 + ((lane ^ (row & 15)) << 4)) = wv;
        }
    }
    __syncthreads();
    {
        const bf16_t* __restrict__ WT = (const bf16_t*)(wsl + WS_WPW);
        const bf16_t* wp0 = WT + (size_t)(64 * wid + r32) * 512 + 8 * hi; const bf16_t* wp1 = wp0 + 32 * 512;
        const LAS unsigned char* ab = (const LAS unsigned char*)cbuf;
        f32x16 acc[2][2] = {};
#pragma unroll 4
        for (int s = 0; s < 32; ++s) {
            const bf16x8 bf0 = *(const bf16x8*)(wp0 + 16 * s), bf1 = *(const bf16x8*)(wp1 + 16 * s);
            const bf16x8 a0 = *(const LAS bf16x8*)(ab + r32 * 2048 + (((2 * s + hi) ^ (r32 & 15)) << 4));
            const bf16x8 a1 = *(const LAS bf16x8*)(ab + (32 + r32) * 2048 + (((2 * s + hi) ^ (r32 & 15)) << 4));
            acc[0][0] = __builtin_amdgcn_mfma_f32_32x32x16_bf16(a0, bf0, acc[0][0], 0, 0, 0);
            acc[0][1] = __builtin_amdgcn_mfma_f32_32x32x16_bf16(a0, bf1, acc[0][1], 0, 0, 0);
            acc[1][0] = __builtin_amdgcn_mfma_f32_32x32x16_bf16(a1, bf0, acc[1][0], 0, 0, 0);
            acc[1][1] = __builtin_amdgcn_mfma_f32_32x32x16_bf16(a1, bf1, acc[1][1], 0, 0, 0);
        }
#pragma unroll
        for (int ct = 0; ct < 2; ++ct) { const int e = 64 * wid + 32 * ct + r32; const float pb = pwb[e];
#pragma unroll
            for (int rt = 0; rt < 2; ++rt)
#pragma unroll
                for (int r = 0; r < 16; ++r) { const size_t m = mbase + 32 * rt + crow(r, hi);
                    MIX[m * DM + 1536 + e] = f2bf((acc[rt][ct][r] + pb) * bf2f(GC[m * 512 + e]));
                    if ((r & 3) == 3) asm volatile("" ::: "memory"); } }
    }
    __syncthreads();
}

constexpr int N_PA = 384, N_SA = 384, N_CV = 130, N_ITEMS = N_PA + N_SA + N_CV;
__device__ __forceinline__ void p2_phase(const Params& p, LAS unsigned char* lds) {
    unsigned* head = (unsigned*)(p.ws + WS_CTL) + 64;
    volatile LAS int* slot = (volatile LAS int*)(lds + LDS_MISC);
    for (;;) {
        if (threadIdx.x == 0) slot[0] = (int)atomicAdd(head, 1u);
        __syncthreads();
        const int it = __builtin_amdgcn_readfirstlane(slot[0]);
        __syncthreads();
        if (it >= N_ITEMS) break;
        if (it < N_PA + N_SA) {
            const int k = it >> 1;
            if ((it & 1) == 0) { const int qt = 7 - k / 48, rem = k % 48;
#ifndef SKIP_PA
 attn_prompt_item(p, lds, rem / 12, rem % 12, qt);
#endif
 }
            else {
#ifndef SKIP_SA
 attn_sample_item(p, lds, k / 12, k % 12);
#endif
 }
        } else {
#ifndef SKIP_CV
 conv_item(p, lds, it - (N_PA + N_SA));
#endif
 }
    }
}

__device__ __forceinline__ void p4_final(const Params& p) {
    const int tid = threadIdx.x, lane = tid & 63, wave = tid >> 6;
    const int gw = blockIdx.x * 8 + wave, NGW = gridDim.x * 8;
    const float* Y = (const float*)(p.ws + WS_Y);
    const f32x4* gp = (const f32x4*)p.in[14] + lane;
    for (int m = gw; m < MROWS; m += NGW) {
        const f32x4* yr = (const f32x4*)(Y + (size_t)m * DM) + lane;
        const f32x4* xr = (const f32x4*)(m < NPR ? p.in[0] + (size_t)m * DM : p.in[1] + (size_t)(m - NPR) * DM) + lane;
        f32x4* orow = (f32x4*)(m < NPR ? p.out + O_YP + (size_t)m * DM : p.out + O_YS + (size_t)(m - NPR) * DM) + lane;
        f32x4 v[8]; float s = 0.f;
#pragma unroll
        for (int j = 0; j < 8; ++j) { v[j] = yr[64 * j]; s += (v[j].x * v[j].x + v[j].y * v[j].y) + (v[j].z * v[j].z + v[j].w * v[j].w); }
        const float rstd = 1.0f / sqrtf(wave_sum(s) * (1.f / DM) + EPS);
#pragma unroll
        for (int j = 0; j < 8; ++j) orow[64 * j] = xr[64 * j] + v[j] * rstd * gp[64 * j];
    }
}

__global__ void __launch_bounds__(512, 2) mega_fwd(Params p) {
    extern __shared__ __attribute__((aligned(16))) unsigned char lds_raw[];
    LAS unsigned char* lds = (LAS unsigned char*)lds_raw;
    const int lo = p.ph_lo, hi = p.ph_hi;
#define IN(k) (lo <= (k) && (k) < hi)
#define SEAM(k) do { if (IN(k) && IN((k) + 1)) cg::this_grid().sync(); } while (0)
#ifndef SKIP_P0
    if (IN(0)) p0_prologue(p, lds);
#endif
    SEAM(0);
#ifndef SKIP_P1
    if (IN(1)) {
        pg8::Gemm g{(const bf16_t*)(p.ws + WS_H), (const bf16_t*)(p.ws + WS_WIN), MPAD, DIN, DM};
        pg8::StaticOrder S; S.init(MPAD, DIN, (int)gridDim.x, (int)blockIdx.x);
        EpiInProj E{(bf16_t*)(p.ws + WS_Z), (bf16_t*)(p.ws + WS_GC), (bf16_t*)(p.ws + WS_UPP), (bf16_t*)(p.ws + WS_UPS), p.out};
        pg8::gemm_phase<EpiInProj, pg8::StaticOrder, false>(lds, g, S, E, nullptr);
    }
#endif
    SEAM(1);
#ifndef SKIP_P2
    if (IN(2)) p2_phase(p, lds);
#endif
    SEAM(2);
#ifndef SKIP_P3
    if (IN(3)) {
        pg8::Gemm g{(const bf16_t*)(p.ws + WS_MIX), (const bf16_t*)(p.ws + WS_WOUT), MPAD, DM, DM};
        pg8::StaticOrder S; S.init(MPAD, DM, (int)gridDim.x, (int)blockIdx.x);
        EpiOutProj E{(float*)(p.ws + WS_Y)};
        pg8::gemm_phase<EpiOutProj, pg8::StaticOrder, false>(lds, g, S, E, nullptr);
    }
#endif
    SEAM(3);
#ifndef SKIP_P4
    if (IN(4)) p4_final(p);
#endif
#undef IN
#undef SEAM
}

extern "C" void kernel_launch(void* const* d_in, const int* in_sizes, int n_in, void* d_out, int out_size, void* d_ws, size_t ws_size, hipStream_t stream) {
    static int grid = 0;
    if (grid == 0) {
        if (n_in != 15 || out_size != 244084736 || ws_size < WS_END) { fprintf(stderr, "kernel_launch: unexpected shapes (n_in %d out %d ws %zu)\n", n_in, out_size, ws_size); grid = -1; return; }
        int dev = 0, cus = 0, per_cu = 0;
        hipGetDevice(&dev); hipDeviceGetAttribute(&cus, hipDeviceAttributeMultiprocessorCount, dev);
        if (hipFuncSetAttribute((const void*)mega_fwd, hipFuncAttributeMaxDynamicSharedMemorySize, LDS_BYTES) != hipSuccess) { fprintf(stderr, "kernel_launch: hipFuncSetAttribute failed\n"); grid = -1; return; }
        hipOccupancyMaxActiveBlocksPerMultiprocessor(&per_cu, (const void*)mega_fwd, 512, LDS_BYTES);
        if (per_cu < 1) { fprintf(stderr, "kernel_launch: occupancy query says %d blocks/CU\n", per_cu); grid = -1; return; }
        grid = cus;
    }
    if (grid < 0) return;
    hipMemsetAsync((char*)d_ws + WS_CTL, 0, CTL_BYTES, stream);
    Params prm{};
    for (int i = 0; i < 15; ++i) prm.in[i] = (const float*)d_in[i];
    prm.out = (float*)d_out; prm.ws = (unsigned char*)d_ws;
#if MK_N_LAUNCHES == 1
    prm.ph_lo = 0; prm.ph_hi = 5;
    void* args[] = {&prm};
    hipError_t e = hipLaunchCooperativeKernel((const void*)mega_fwd, dim3(grid), dim3(512), args, LDS_BYTES, stream);
    if (e != hipSuccess) fprintf(stderr, "cooperative launch failed: %s (grid %d)\n", hipGetErrorString(e), grid);
#else
    for (int ph = 0; ph < 5; ++ph) { prm.ph_lo = ph; prm.ph_hi = ph + 1; hipLaunchKernelGGL(mega_fwd, dim3(grid), dim3(512), LDS_BYTES, stream, prm); }
#endif
}
```

```cpp
#include <hip/hip_runtime.h>
#include <hip/hip_cooperative_groups.h>
#include <cstdio>
#include <cstdint>
namespace cg = cooperative_groups;
#ifndef PROBE_MASK
#define PROBE_MASK 7
#endif
#ifndef PROBE_REP
#define PROBE_REP 0
#endif
#ifndef PROBE_CVS
#define PROBE_CVS 0
#endif
#ifndef PROBE_T
#define PROBE_T 0
#endif
#ifndef PROBE_RL
#define PROBE_RL 0
#endif
#ifndef PROBE_P0
#define PROBE_P0 0
#endif
#ifndef PROBE_DUP
#define PROBE_DUP -1
#endif
#ifndef MK_N_LAUNCHES
#define MK_N_LAUNCHES 1
#endif
namespace pg8 {
#define PG8_LAS __attribute__((address_space(3)))
typedef unsigned short bf16_t;
typedef short bf16x8 __attribute__((ext_vector_type(8)));
typedef float f32x4 __attribute__((ext_vector_type(4)));
typedef unsigned u32x4 __attribute__((ext_vector_type(4)));
constexpr int BM = 256, BK = 64, HALF = 128, HTB = HALF * BK * 2  , STAGE_BYTES = 8 * HTB, NXCD = 8, WGM = 8;

__host__ __device__ __forceinline__ int lds_byte(int r, int c) { const int st = (r >> 4) * 2 + (c >> 5), rr = r & 15, cc = c & 31, ob = rr * 64 + cc * 2; return st * 1024 + (ob ^ (((ob >> 9) & 1) << 5)); }
__host__ __device__ __forceinline__ void stage_rc(int b, int& R, int& C) { const int st = b / 1024, sb = b % 1024, swz = sb ^ (((sb >> 9) & 1) << 5); R = (st >> 1) * 16 + swz / 64; C = (st & 1) * 32 + (swz % 64) / 2; }
__host__ __device__ __forceinline__ int perm32(int rho) { const int n = rho >> 4, i = rho & 15; return 8 * (i >> 2) + 4 * n + (i & 3); }

struct Unit { int pm, pn; };
struct Gemm { const bf16_t* A; const bf16_t* Bt; int M, N, K; };

struct StaticOrder {
    int nM, nN, nwg, G, c;
    __host__ __device__ void init(int M, int N, int G_, int c_) { nM = M / BM; nN = N / BM; nwg = nM * nN; G = G_; c = c_; }
    __host__ __device__ bool next(int i, Unit& u) const {
        const long L = (long)i * G + c; if (L >= nwg) return false;
        int wgid = (int)L; { const int q = nwg / NXCD, r = nwg % NXCD, xcd = wgid % NXCD, off = wgid / NXCD; wgid = (xcd < r ? xcd * (q + 1) : r * (q + 1) + (xcd - r) * q) + off; }
        const int nig = WGM * nN, gid = wgid / nig, fm = gid * WGM, gsz = (nM - fm) < WGM ? (nM - fm) : WGM;
        u.pm = fm + ((wgid % nig) % gsz); u.pn = (wgid % nig) / gsz; return true;
    }
    __device__ __forceinline__ void a_ready(const Unit&) const {}
    __device__ __forceinline__ void done(const Unit&) const {}
};
__device__ __forceinline__ unsigned cvt_pk_bf16(float lo, float hi) { unsigned r; asm volatile("v_cvt_pk_bf16_f32 %0, %1, %2" : "=v"(r) : "v"(lo), "v"(hi)); return r; }
template <class Epi, class Sched, class Rider, bool STAMP = false>
__device__ __forceinline__ void gemm_phase(PG8_LAS unsigned char* lds, const Gemm g, const Sched& S, const Epi& E, Rider& R, unsigned long long* stamps) {
    const int tid = threadIdx.x, wid = __builtin_amdgcn_readfirstlane(tid >> 6), lane = tid & 63, wr = wid >> 2, wc = wid & 3, fr = lane & 15, fq = lane >> 4;
    const int K = g.K, nt = K / BK;
    int ts_lo = 0, ts_hi = 0, nts = 0; const unsigned long long rt_entry = STAMP ? (unsigned long long)wall_clock64() : 0ull;
#define PG8_STAMP() do { if (STAMP && wid == 0 && nts < 64) { const unsigned long long _c = (unsigned long long)clock64(); \
        ts_lo = (lane == nts) ? (int)(unsigned)_c : ts_lo; ts_hi = (lane == nts) ? (int)(unsigned)(_c >> 32) : ts_hi; ++nts; } } while (0)
    PG8_STAMP();
    unsigned voffA[2], voffB[2];
#pragma unroll
    for (int i = 0; i < 2; ++i) { int R, C; stage_rc(tid * 16 + i * 8192, R, C); const int Rb = Epi::PERM ? ((R & ~31) + perm32(R & 31)) : R;
        voffA[i] = (unsigned)(R * K + C) * 2u; voffB[i] = (unsigned)(Rb * K + C) * 2u; }
    const size_t kstep = (size_t)(BK * 2);
    const size_t hstep = (size_t)HALF * K * 2;
    const size_t tstep = 2 * hstep;
    const unsigned ldsw = (unsigned)wid * 1024u;
    const int aoff = lds_byte(wr * 64 + fr, fq * 8), boff = lds_byte(wc * 32 + fr, fq * 8);
#define PG8_SA(b, h) (((b) * 2 + (h)) * HTB)
#define PG8_SB(b, h) ((4 + (b) * 2 + (h)) * HTB)
#define PG8_STAGE(bufoff, gbase, voff) do { _Pragma("unroll") for (int _i = 0; _i < 2; ++_i) \
        __builtin_amdgcn_global_load_lds((const unsigned*)((const char*)(gbase) + (voff)[_i]), (PG8_LAS unsigned*)(lds + (bufoff) + ldsw + _i * 8192), 16, 0, 0); } while (0)
#define PG8_LDA(dst, b, h) do { _Pragma("unroll") for (int m = 0; m < 4; ++m) _Pragma("unroll") for (int k = 0; k < 2; ++k) dst[m][k] = *(const PG8_LAS bf16x8*)(lds + PG8_SA(b, h) + aoff + m * 2048 + k * 1024); } while (0)
#define PG8_LDB(dst, b, h) do { _Pragma("unroll") for (int n = 0; n < 2; ++n) _Pragma("unroll") for (int k = 0; k < 2; ++k) dst[n][k] = *(const PG8_LAS bf16x8*)(lds + PG8_SB(b, h) + boff + n * 2048 + k * 1024); } while (0)
#define PG8_MMA(ai, bj, At, Bt) do { __builtin_amdgcn_s_setprio(1); _Pragma("unroll") for (int m = 0; m < 4; ++m) _Pragma("unroll") for (int n = 0; n < 2; ++n) _Pragma("unroll") for (int k = 0; k < 2; ++k) \
        acc[ai][bj][m][n] = __builtin_amdgcn_mfma_f32_16x16x32_bf16(Bt[n][k], At[m][k], acc[ai][bj][m][n], 0, 0, 0); __builtin_amdgcn_s_setprio(0); } while (0)
#define PG8_WAIT_V(n) asm volatile("s_waitcnt vmcnt(" #n ")" ::: "memory")
#define PG8_WAIT_L(n) asm volatile("s_waitcnt lgkmcnt(" #n ")" ::: "memory")
#define PG8_BAR __builtin_amdgcn_s_barrier()
#define PG8_SCHED __builtin_amdgcn_sched_barrier(0)
    Unit cur, nxt; int ui = 0;
    if (!S.next(0, cur)) return;
    R.before_first();
    f32x4 acc[2][2][4][2];
#pragma unroll
    for (int a = 0; a < 2; ++a)
#pragma unroll
        for (int b = 0; b < 2; ++b)
#pragma unroll
            for (int m = 0; m < 4; ++m)
#pragma unroll
                for (int n = 0; n < 2; ++n) acc[a][b][m][n] = (f32x4){0.f, 0.f, 0.f, 0.f};
    bf16x8 At[4][2], B0[2][2], B1[2][2];
    const char* cA = (const char*)g.A + (size_t)cur.pm * tstep; const char* cB = (const char*)g.Bt + (size_t)cur.pn * tstep;
    S.a_ready(cur);
    PG8_STAGE(PG8_SB(0, 0), cB, voffB); PG8_STAGE(PG8_SA(0, 0), cA, voffA); PG8_STAGE(PG8_SB(0, 1), cB + hstep, voffB); PG8_STAGE(PG8_SA(0, 1), cA + hstep, voffA);
    if (wr == 1) PG8_BAR;
    PG8_WAIT_V(4); PG8_BAR;
    PG8_STAGE(PG8_SB(1, 0), cB + kstep, voffB); PG8_STAGE(PG8_SA(1, 0), cA + kstep, voffA); PG8_STAGE(PG8_SB(1, 1), cB + hstep + kstep, voffB);
    PG8_WAIT_V(6); PG8_BAR;
    PG8_STAMP();
    for (;;) {
        const bool has_next = S.next(ui + 1, nxt);
        const char* nA = has_next ? (const char*)g.A + (size_t)nxt.pm * tstep : cA; const char* nB = has_next ? (const char*)g.Bt + (size_t)nxt.pn * tstep : cB;
        for (int t = 0; t < nt; t += 2) {
            const bool last = (t == nt - 2);
            const char* a1 = cA + (size_t)(t + 1) * kstep;
            const char* a2 = last ? nA : cA + (size_t)(t + 2) * kstep; const char* b2 = last ? nB : cB + (size_t)(t + 2) * kstep;
            const char* a3 = a2 + kstep; const char* b3 = b2 + kstep;
            if (last && has_next) S.a_ready(nxt);
            PG8_LDB(B0, 0, 0); PG8_SCHED; PG8_LDA(At, 0, 0); PG8_STAGE(PG8_SA(1, 1), a1 + hstep, voffA);
            PG8_WAIT_L(8); PG8_BAR; PG8_WAIT_L(0); PG8_MMA(0, 0, At, B0); PG8_BAR; PG8_SCHED;
            PG8_LDB(B1, 0, 1); PG8_STAGE(PG8_SB(0, 0), b2, voffB);
            PG8_BAR; PG8_WAIT_L(0); PG8_MMA(0, 1, At, B1); PG8_BAR;
            PG8_LDA(At, 0, 1); PG8_STAGE(PG8_SA(0, 0), a2, voffA);
            PG8_BAR; PG8_WAIT_L(0); PG8_MMA(1, 0, At, B0); PG8_BAR; PG8_SCHED;
            PG8_STAGE(PG8_SB(0, 1), b2 + hstep, voffB);
            PG8_WAIT_V(6); R.store(); PG8_BAR; PG8_MMA(1, 1, At, B1); PG8_BAR;
            PG8_LDB(B0, 1, 0); PG8_SCHED; PG8_LDA(At, 1, 0); PG8_STAGE(PG8_SA(0, 1), a2 + hstep, voffA); R.load();
            PG8_WAIT_L(8); PG8_BAR; PG8_WAIT_L(0); PG8_MMA(0, 0, At, B0); PG8_BAR; PG8_SCHED;
            PG8_LDB(B1, 1, 1); PG8_STAGE(PG8_SB(1, 0), b3, voffB);
            PG8_BAR; PG8_WAIT_L(0); PG8_MMA(0, 1, At, B1); PG8_BAR;
            PG8_LDA(At, 1, 1); PG8_STAGE(PG8_SA(1, 0), a3, voffA);
            PG8_BAR; PG8_WAIT_L(0); PG8_MMA(1, 0, At, B0); PG8_BAR; PG8_SCHED;
            PG8_STAGE(PG8_SB(1, 1), b3 + hstep, voffB);
            R.wait8(); PG8_BAR; PG8_MMA(1, 1, At, B1); PG8_BAR;
        }
        PG8_STAMP();
        if constexpr (!Epi::AFTER_DRAIN) { E(acc, cur, wr, wc, fr, fq); S.done(cur); }
        R.unit_done(ui);
        PG8_STAMP();
        if (!has_next) break;
#pragma unroll
        for (int a = 0; a < 2; ++a)
#pragma unroll
            for (int b = 0; b < 2; ++b)
#pragma unroll
                for (int m = 0; m < 4; ++m)
#pragma unroll
                    for (int n = 0; n < 2; ++n) acc[a][b][m][n] = (f32x4){0.f, 0.f, 0.f, 0.f};
        cur = nxt; cA = nA; cB = nB; ++ui;
    }
    PG8_WAIT_V(0); R.store();
    if (wr == 0) PG8_BAR;
    PG8_BAR;
    if constexpr (Epi::AFTER_DRAIN) { E.fused(acc, cur, wr, wc, fr, fq, lds, wid, lane); S.done(cur); }
    PG8_STAMP();
    if (STAMP && wid == 0) { stamps[lane] = lane < nts ? (((unsigned long long)(unsigned)ts_hi << 32) | (unsigned)ts_lo) : 0ull;
        if (lane == 62) stamps[62] = rt_entry; if (lane == 63) stamps[63] = (unsigned long long)wall_clock64(); }
#undef PG8_STAMP
#undef PG8_SA
#undef PG8_SB
#undef PG8_STAGE
#undef PG8_LDA
#undef PG8_LDB
#undef PG8_MMA
#undef PG8_WAIT_V
#undef PG8_WAIT_L
#undef PG8_BAR
#undef PG8_SCHED
}
}

#define LAS __attribute__((address_space(3)))
typedef unsigned short bf16_t;
typedef short bf16x8 __attribute__((ext_vector_type(8)));
typedef short s16x4 __attribute__((ext_vector_type(4)));
typedef float f32x4 __attribute__((ext_vector_type(4)));
typedef float f32x16 __attribute__((ext_vector_type(16)));
typedef unsigned u32x4 __attribute__((ext_vector_type(4)));
typedef unsigned u32x2 __attribute__((ext_vector_type(2)));
using pg8::cvt_pk_bf16;

#define XB_TMO      128
#define XB_XCNT(j)  (256  + 64 * (j))
#define XB_XSUB(j)  (1280 + 64 * (j))
#define XB_XGEN(j)  (2304 + 64 * (j))
#define XB_TOP      3328
#define XB_TOPGEN   3392
#define XCD_BAR_WORDS 3456
#define XB_SPIN_CAP (1u << 18)

__device__ __forceinline__ unsigned xb_ld(unsigned* p)              { return __hip_atomic_load(p, __ATOMIC_RELAXED, __HIP_MEMORY_SCOPE_AGENT); }
__device__ __forceinline__ unsigned xb_add(unsigned* p, unsigned v) { return __hip_atomic_fetch_add(p, v, __ATOMIC_RELAXED, __HIP_MEMORY_SCOPE_AGENT); }
__device__ __forceinline__ unsigned xb_xcc_id() { return (unsigned)__builtin_amdgcn_s_getreg((3 << 11) | 20) & 0xFu; }
#define XB_SPIN(cond, bar) do { unsigned _sp = 0; while (cond) { __builtin_amdgcn_s_sleep(1); \
    if ((++_sp & 255u) == 0u) { if (xb_ld(&(bar)[XB_TMO])) break; if (_sp > XB_SPIN_CAP) { atomicAdd(&(bar)[XB_TMO], 1u); break; } } } } while (0)

struct XcdBarrier {
    unsigned* bar; unsigned x;
    volatile LAS unsigned* st;
};

__device__ __forceinline__ XcdBarrier xcd_barrier_post(unsigned* bar, volatile LAS unsigned* st) {
    XcdBarrier b; b.bar = bar; b.x = xb_xcc_id(); b.st = st;
    if (threadIdx.x == 0) (void)xb_add(&bar[XB_XCNT(b.x)], 1u);
    return b;
}
__device__ __forceinline__ void xcd_barrier_complete(unsigned* bar, unsigned x, unsigned& nloc, unsigned& nx) {
    const unsigned G = gridDim.x * gridDim.y * gridDim.z;
    unsigned sum, cnt, mine, sp = 0u;
    for (;;) {
        sum = 0u; cnt = 0u; mine = 0u;
#pragma unroll
        for (unsigned j = 0; j < 16; ++j) { const unsigned c = xb_ld(&bar[XB_XCNT(j)]); sum += c; cnt += (c > 0u) ? 1u : 0u; mine = (j == x) ? c : mine; }
        if (sum == G) break;
        __builtin_amdgcn_s_sleep(1);
        if ((++sp & 255u) == 0u) { if (xb_ld(&bar[XB_TMO])) break; if (sp > XB_SPIN_CAP) { atomicAdd(&bar[XB_TMO], 1u); break; } }
    }
    nloc = mine > 0u ? mine : 1u; nx = cnt > 0u ? cnt : 1u;
}

__device__ __forceinline__ void xcd_barrier(const XcdBarrier& b) {
    asm volatile("s_waitcnt vmcnt(0)" ::: "memory");
    __syncthreads();
    if (threadIdx.x == 0) {
        unsigned* bar = b.bar;
        __builtin_amdgcn_s_waitcnt(0);
        unsigned nloc = b.st[0], nx = b.st[1];
        if (nloc == 0u) { xcd_barrier_complete(bar, b.x, nloc, nx); b.st[0] = nloc; b.st[1] = nx; }
        const unsigned old = xb_add(&bar[XB_XSUB(b.x)], 1u);
        const unsigned gen = old / nloc;
        if (old + 1u == (gen + 1u) * nloc) {
            __builtin_amdgcn_fence(__ATOMIC_RELEASE, "agent");
            asm volatile("s_waitcnt vmcnt(0)" ::: "memory");
            const unsigned og = xb_add(&bar[XB_TOP], 1u);
            const unsigned tg = og / nx;
            if (og + 1u == (tg + 1u) * nx) xb_add(&bar[XB_TOPGEN], 1u);
            else XB_SPIN(xb_ld(&bar[XB_TOPGEN]) == tg, bar);
            __builtin_amdgcn_fence(__ATOMIC_ACQUIRE, "agent");
            xb_add(&bar[XB_XGEN(b.x)], 1u);
            asm volatile("s_waitcnt vmcnt(0)" ::: "memory");
        } else {
            XB_SPIN(xb_ld(&bar[XB_XGEN(b.x)]) == gen, bar);
            __builtin_amdgcn_fence(__ATOMIC_ACQUIRE, "agent");
            asm volatile("s_waitcnt vmcnt(0)" ::: "memory");
        }
    }
    __syncthreads();
}

constexpr int DM = 2048, NPR = 8192, NSM = 128, MROWS = 8320, MPAD = 8448;
constexpr int DIN = 7680, SEQ = 2048, NBP = 4, NBS = 32, DT = 4, NH = 12;
constexpr int LDZ = 6144;
constexpr float EPS = 1e-6f;
constexpr float LOG2E = 1.4426950408889634f;
constexpr float QSCALE = 0.08838834764831845f * 1.4426950408889634f;
constexpr float NEGBIG = -1e30f;
constexpr size_t O_YP = 0, O_YS = 16777216, O_CP = 17039360, O_KVP = 17100800, O_CS = 42266624, O_KVS = 42758144;
constexpr size_t MiB = 1u << 20;
constexpr size_t WS_CTL = 0, CTL_BYTES = 65536;
constexpr size_t WS_WIN = 1 * MiB, WS_WOUT = 32 * MiB, WS_WPW = 40 * MiB, WS_TAB = 41 * MiB, WS_H = 42 * MiB, WS_Z = 76 * MiB, WS_GC = 176 * MiB;
constexpr size_t WS_UPP = 186 * MiB, WS_UPS = 195 * MiB, WS_MIX = 198 * MiB, WS_Y = 232 * MiB, WS_END = 300 * MiB;
constexpr int TAB_NEG = 384, TAB_N = 2688;
constexpr int LDS_TAB = 131072, LDS_AL = LDS_TAB + TAB_N * 4, LDS_MISC = LDS_AL + 2048, LDS_BYTES = 147456;
static_assert(LDS_MISC + 256 <= LDS_BYTES, "LDS map");

struct Params { const float* in[15]; float* out; unsigned char* ws; int ph_lo, ph_hi; };

__device__ __forceinline__ size_t opaque0() { size_t z = 0; asm volatile("" : "+s"(z)); return z; }
template <class V> __device__ __forceinline__ void st16_hidden(void* ptr, V v) { static_assert(sizeof(V) == 16, ""); asm volatile("global_store_dwordx4 %0, %1, off\n\ts_nop 1" :: "v"(ptr), "v"(v) : "memory"); }
template <class V> __device__ __forceinline__ void st16_hidden_nt(void* ptr, V v) { static_assert(sizeof(V) == 16, ""); asm volatile("global_store_dwordx4 %0, %1, off nt\n\ts_nop 1" :: "v"(ptr), "v"(v) : "memory"); }
__device__ __forceinline__ void st8_hidden(void* ptr, unsigned long long v) { asm volatile("global_store_dwordx2 %0, %1, off\n\ts_nop 1" :: "v"(ptr), "v"(v) : "memory"); }
__device__ __forceinline__ float bf2f(bf16_t v) { return __uint_as_float(((unsigned)v) << 16); }
__device__ __forceinline__ bf16_t f2bf(float f) { unsigned u = __float_as_uint(f); return (bf16_t)((u + 0x7fffu + ((u >> 16) & 1u)) >> 16); }
__device__ __forceinline__ float wave_sum(float v) {
#pragma unroll
    for (int o = 1; o < 64; o <<= 1) v += __shfl_xor(v, o);
    return v;
}
__device__ __forceinline__ float fast_sigmoid(float x) { return __builtin_amdgcn_rcpf(1.0f + __builtin_amdgcn_exp2f(-x * LOG2E)); }
__device__ __forceinline__ float silu_f(float x) { return x * fast_sigmoid(x); }

__device__ __forceinline__ void p0_transpose_item(const float* __restrict__ W, int K, int N, bf16_t* __restrict__ WT, int k0, int nsrc0, int ndst0, LAS float* scr, int lane) {
    f32x4 tv[16];
    const int lr = lane >> 4, lc = 4 * (lane & 15);
#pragma unroll
    for (int i = 0; i < 16; ++i) tv[i] = __builtin_nontemporal_load((const f32x4*)(W + (size_t)(k0 + 4 * i + lr) * N + nsrc0 + lc));
#pragma unroll
    for (int i = 0; i < 16; ++i) { LAS float* d = scr + (4 * i + lr) * 65 + lc; d[0] = tv[i].x; d[1] = tv[i].y; d[2] = tv[i].z; d[3] = tv[i].w; }
    asm volatile("s_waitcnt lgkmcnt(0)" ::: "memory");
    const int c = lane & 7;
#pragma unroll
    for (int j = 0; j < 8; ++j) { const int n = (lane >> 3) + 8 * j; const LAS float* sp = scr + (8 * c) * 65 + n;
        u32x4 o; o.x = cvt_pk_bf16(sp[0 * 65], sp[1 * 65]); o.y = cvt_pk_bf16(sp[2 * 65], sp[3 * 65]); o.z = cvt_pk_bf16(sp[4 * 65], sp[5 * 65]); o.w = cvt_pk_bf16(sp[6 * 65], sp[7 * 65]);
        *(u32x4*)(WT + (size_t)(ndst0 + n) * K + k0 + 8 * c) = o; }
    asm volatile("s_waitcnt lgkmcnt(0)" ::: "memory");
}
__device__ __forceinline__ int win_src_col(int nv) {
    if (nv < 6144 || nv >= 7168) return nv;
    const int g = (nv - 6144) >> 8, r = (nv - 6144) & 255;
    return r < 128 ? 6144 + 128 * g + r : 6656 + 128 * g + (r - 128);
}
__device__ __forceinline__ int rel_bucket(int dist) {
    if (dist < 16) return dist;
    const double d = (double)dist;
    int lb = 16 + (int)(log(d / 16.0) / log(128.0) * 16.0);
    return lb < 31 ? lb : 31;
}
__device__ __forceinline__ void p0_prologue(const Params& p, LAS unsigned char* lds) {
    const int tid = threadIdx.x, lane = tid & 63, wave = tid >> 6;
    const int gw = blockIdx.x * 8 + wave, NGW = gridDim.x * 8;
    const size_t gt = (size_t)blockIdx.x * 512 + tid, NGT = (size_t)gridDim.x * 512;
    unsigned char* ws = p.ws;
    _Pragma("unroll 1") for (int rep_ = 0; rep_ < (PROBE_P0 == 1 ? 3 : 1); ++rep_)
    {
        LAS float* scr = (LAS float*)(lds + wave * 17408);
        constexpr int I_IN = 32 * 120, I_OUT = 32 * 32, I_PW = 8 * 8;
        bf16_t* WinT = (bf16_t*)(ws + WS_WIN); bf16_t* WoutT = (bf16_t*)(ws + WS_WOUT); bf16_t* WpwT = (bf16_t*)(ws + WS_WPW);
        for (int it = gw; it < I_IN + I_OUT + I_PW; it += NGW) {
            int r = it;
            if (r < I_IN) { const int kb = r / 120, nb = r % 120; p0_transpose_item(p.in[6], 2048, DIN, WinT, 64 * kb, win_src_col(64 * nb), 64 * nb, scr, lane); continue; } r -= I_IN;
            if (r < I_OUT) { const int kb = r / 32, nb = r % 32; p0_transpose_item(p.in[13], 2048, 2048, WoutT, 64 * kb, 64 * nb, 64 * nb, scr, lane); continue; } r -= I_OUT;
            { const int kb = r / 8, nb = r % 8; p0_transpose_item(p.in[11], 512, 512, WpwT, 64 * kb, 64 * nb, 64 * nb, scr, lane); }
        }
    }
    _Pragma("unroll 1") for (int rep_ = 0; rep_ < (PROBE_P0 == 2 ? 3 : 1); ++rep_)
    {
        bf16_t* H = (bf16_t*)(ws + WS_H);
        const f32x4* gp = (const f32x4*)p.in[5] + lane;
        f32x4 gq[8];
#pragma unroll
        for (int j = 0; j < 8; ++j) gq[j] = gp[64 * j];
        for (int m0 = gw; m0 < MPAD; m0 += 2 * NGW) {
            const int m1 = m0 + NGW; const bool r0 = m0 < MROWS, r1 = m1 < MROWS;
            const float* x0 = m0 < NPR ? p.in[0] + (size_t)m0 * DM : p.in[1] + (size_t)(m0 - NPR) * DM;
            const float* x1 = m1 < NPR ? p.in[0] + (size_t)m1 * DM : p.in[1] + (size_t)(m1 - NPR) * DM;
            f32x4 v0[8], v1[8];
#pragma unroll
            for (int j = 0; j < 8; ++j) { v0[j] = r0 ? __builtin_nontemporal_load((const f32x4*)x0 + lane + 64 * j) : (f32x4){0.f, 0.f, 0.f, 0.f};
                                          v1[j] = r1 ? __builtin_nontemporal_load((const f32x4*)x1 + lane + 64 * j) : (f32x4){0.f, 0.f, 0.f, 0.f}; }
            __builtin_amdgcn_sched_barrier(0);
            float s0 = 0.f, s1 = 0.f;
#pragma unroll
            for (int j = 0; j < 8; ++j) { s0 += (v0[j].x * v0[j].x + v0[j].y * v0[j].y) + (v0[j].z * v0[j].z + v0[j].w * v0[j].w); s1 += (v1[j].x * v1[j].x + v1[j].y * v1[j].y) + (v1[j].z * v1[j].z + v1[j].w * v1[j].w); }
            const float rs0 = 1.0f / sqrtf(wave_sum(s0) * (1.f / DM) + EPS), rs1 = 1.0f / sqrtf(wave_sum(s1) * (1.f / DM) + EPS);
            unsigned long long* o0 = (unsigned long long*)(H + (size_t)m0 * DM) + lane; unsigned long long* o1 = (unsigned long long*)(H + (size_t)m1 * DM) + lane;
#pragma unroll
            for (int j = 0; j < 8; ++j) { const f32x4 g = gq[j];
                o0[64 * j] = (unsigned long long)cvt_pk_bf16(v0[j].x * rs0 * g.x, v0[j].y * rs0 * g.y) | ((unsigned long long)cvt_pk_bf16(v0[j].z * rs0 * g.z, v0[j].w * rs0 * g.w) << 32);
                if (m1 < MPAD) o1[64 * j] = (unsigned long long)cvt_pk_bf16(v1[j].x * rs1 * g.x, v1[j].y * rs1 * g.y) | ((unsigned long long)cvt_pk_bf16(v1[j].z * rs1 * g.z, v1[j].w * rs1 * g.w) << 32); }
        }
    }
    {
        bf16_t* UPP = (bf16_t*)(ws + WS_UPP); bf16_t* UPS = (bf16_t*)(ws + WS_UPS);
        for (size_t i = gt; i < (size_t)NBP * 30 * 512; i += NGT) { const size_t b = i / (30 * 512), r = i % (30 * 512); UPP[b * 2078 * 512 + r] = 0; }
        const float* cc = p.in[2];
        for (size_t i = gt; i < (size_t)NBS * 30 * 512; i += NGT) { const size_t b = i / (30 * 512), r = i % (30 * 512); const float v = cc[i];
            UPS[b * 34 * 512 + r] = f2bf(v);
            if (r >= 4 * 512) p.out[O_CS + b * 30 * 512 + (r - 4 * 512)] = v; }
    }
    _Pragma("unroll 1") for (int rep_ = 0; rep_ < (PROBE_P0 == 4 ? 3 : 1); ++rep_)
    {
        float* tabg = (float*)(ws + WS_TAB); const float* rb = p.in[4];
        for (size_t i = gt; i < (size_t)NH * TAB_N; i += NGT) {
            const int h = (int)(i / TAB_N), dist = (int)(i % TAB_N) - TAB_NEG; float v = NEGBIG;
            if (dist >= 0 && dist <= 2048) {
                const int mult = (dist <= 128 ? 1 : 0) + (((dist & 3) == 0 && dist <= 512) ? 1 : 0) + ((dist & 15) == 0 ? 1 : 0);
                if (mult > 0) v = rb[rel_bucket(dist) * NH + h] * LOG2E + (mult == 1 ? 0.f : (mult == 2 ? 1.f : 1.5849625007211562f));
            }
            tabg[i] = v;
        }
    }
}

constexpr int POOL_FIRST = 0;
constexpr int CP_STATIC = 6, CP_POOL = (12 - CP_STATIC) * 256;
struct CopyBurst {
    const float* cache; float* out_kvs; int slot; bool done;
    __device__ __forceinline__ void init(const float* c, float* o, int slot_) { cache = c; out_kvs = o; slot = slot_; done = false; }
    __device__ __forceinline__ void burst(int owner, int gi0, int gi1) {
        const size_t b = (size_t)(owner >> 3), part = (size_t)(owner & 7);
        const f32x4* src = (const f32x4*)cache + b * ((size_t)2048 * 768) + threadIdx.x + 4 * 768;
        f32x4* dst = (f32x4*)out_kvs + b * ((size_t)2048 * 768) + threadIdx.x;
        f32x4 va[9], vb[9];
#pragma unroll
        for (int u = 0; u < 9; ++u) { va[u] = (f32x4){0.f, 0.f, 0.f, 0.f}; vb[u] = (f32x4){0.f, 0.f, 0.f, 0.f}; }
#define CB_LOAD(V, P) do { _Pragma("unroll") for (int u = 0; u < 9; ++u) asm volatile("global_load_dwordx4 %0, %1, off nt" : "+v"(V[u]) : "v"((P) + u * 512) : "memory"); } while (0)
#define CB_STORE(V, P) do { _Pragma("unroll") for (int u = 0; u < 9; ++u) asm volatile("global_store_dwordx4 %0, %1, off nt\n\ts_nop 1" :: "v"((P) + u * 512), "v"(V[u]) : "memory"); } while (0)
#define CB_WAIT9(V) asm volatile("s_waitcnt vmcnt(9)" ::: "memory")
#define CB_WAIT0(V) asm volatile("s_waitcnt vmcnt(0)" ::: "memory")
        asm volatile("s_waitcnt vmcnt(0)" ::: "memory");
        const size_t g0 = (size_t)(12 * part) * 16 * 768;
#pragma unroll 1
        for (int gi = gi0; gi < gi1; ++gi) {
            const size_t oa = g0 + (size_t)gi * 16 * 768, ob = oa + 4608;
            CB_LOAD(va, src + oa);
            CB_LOAD(vb, src + ob);
            CB_WAIT9(va);
            CB_STORE(va, dst + oa);
            CB_WAIT0(vb);
            CB_STORE(vb, dst + ob);
        }
        asm volatile("s_waitcnt vmcnt(0)" ::: "memory");
#undef CB_LOAD
#undef CB_STORE
#undef CB_WAIT9
#undef CB_WAIT0
    }
    __device__ __forceinline__ void before_first() { if (slot == 0) { burst((int)blockIdx.x, 0, CP_STATIC); done = true; } }
    __device__ __forceinline__ void unit_done(int ui) { if (!done && ui + 1 == slot) { burst((int)blockIdx.x, 0, CP_STATIC); done = true; } }
    __device__ __forceinline__ void finish() { if (!done) { burst((int)blockIdx.x, 0, CP_STATIC); done = true; } }
    __device__ __forceinline__ void load() {} __device__ __forceinline__ void store() {}
    __device__ __forceinline__ void wait8() { asm volatile("s_waitcnt vmcnt(6)" ::: "memory"); }
};
struct NoRider { __device__ __forceinline__ void load() {} __device__ __forceinline__ void store() {} __device__ __forceinline__ void wait8() { asm volatile("s_waitcnt vmcnt(6)" ::: "memory"); }
    __device__ __forceinline__ void before_first() {} __device__ __forceinline__ void unit_done(int) {} };

struct EpiInProj {
    static constexpr bool PERM = true, AFTER_DRAIN = false;
    bf16_t* Z; bf16_t* GC; bf16_t* UPP; bf16_t* UPS; float* out;
    __device__ __forceinline__ void operator()(const f32x4 (&acc)[2][2][4][2], const pg8::Unit& u, int wr, int wc, int fr, int fq) const {
        const int pn = u.pn;
        const int row0 = u.pm * 256 + wr * 64 + fr, cw = wc * 32 + 8 * fq;
        if (pn < 24) {
            const int kind = pn < 6 ? 0 : (pn < 18 ? 1 : 2);
#pragma unroll
            for (int ai = 0; ai < 2; ++ai)
#pragma unroll
                for (int m = 0; m < 4; ++m) {
                    const int r = row0 + ai * 128 + m * 16;
                    if (r >= MROWS) continue;
                    bf16_t* zrow = Z + (size_t)r * LDZ + pn * 256 + cw;
                    float* kvrow = nullptr;
                    if (kind == 1) { const size_t orow = r < NPR ? (size_t)r : (size_t)((r - NPR) >> 2) * 2048 + 2044 + ((r - NPR) & 3);
                        kvrow = out + (r < NPR ? O_KVP : O_KVS) + orow * 3072 + (pn * 256 - 1536) + cw; }
#pragma unroll
                    for (int bj = 0; bj < 2; ++bj) { f32x4 v0 = acc[ai][bj][m][0], v1 = acc[ai][bj][m][1];
                        if (kind == 1) { __builtin_nontemporal_store(v0, (f32x4*)(kvrow + bj * 128)); __builtin_nontemporal_store(v1, (f32x4*)(kvrow + bj * 128 + 4)); }
                        if (kind == 0) { v0 *= QSCALE; v1 *= QSCALE; }
                        if (kind == 2) {
#pragma unroll
                            for (int j = 0; j < 4; ++j) { v0[j] = silu_f(v0[j]); v1[j] = silu_f(v1[j]); } }
                        u32x4 w; w.x = cvt_pk_bf16(v0[0], v0[1]); w.y = cvt_pk_bf16(v0[2], v0[3]); w.z = cvt_pk_bf16(v1[0], v1[1]); w.w = cvt_pk_bf16(v1[2], v1[3]);
                        *(u32x4*)(zrow + bj * 128) = w; }
                }
        } else if (pn < 28) {
            const int cu = (pn - 24) * 128 + cw;
#pragma unroll
            for (int ai = 0; ai < 2; ++ai)
#pragma unroll
                for (int m = 0; m < 4; ++m) {
                    const int r = row0 + ai * 128 + m * 16;
                    if (r >= MROWS) continue;
                    f32x4 a0 = acc[ai][0][m][0], a1 = acc[ai][0][m][1]; const f32x4 b0 = acc[ai][1][m][0], b1 = acc[ai][1][m][1];
#pragma unroll
                    for (int j = 0; j < 4; ++j) { a0[j] *= fast_sigmoid(b0[j]); a1[j] *= fast_sigmoid(b1[j]); }
                    u32x4 w; w.x = cvt_pk_bf16(a0[0], a0[1]); w.y = cvt_pk_bf16(a0[2], a0[3]); w.z = cvt_pk_bf16(a1[0], a1[1]); w.w = cvt_pk_bf16(a1[2], a1[3]);
                    if (r < NPR) { const int b = r >> 11, t = r & 2047;
                        *(u32x4*)(UPP + ((size_t)b * 2078 + 30 + t) * 512 + cu) = w;
                        if (t >= 2018) { float* o = out + O_CP + ((size_t)b * 30 + (t - 2018)) * 512 + cu; *(f32x4*)o = a0; *(f32x4*)(o + 4) = a1; } }
                    else { const int b = (r - NPR) >> 2, j = (r - NPR) & 3;
                        *(u32x4*)(UPS + ((size_t)b * 34 + 30 + j) * 512 + cu) = w;
                        float* o = out + O_CS + ((size_t)b * 30 + 26 + j) * 512 + cu; *(f32x4*)o = a0; *(f32x4*)(o + 4) = a1; }
                }
        } else {
#pragma unroll
            for (int ai = 0; ai < 2; ++ai)
#pragma unroll
                for (int m = 0; m < 4; ++m) {
                    const int r = row0 + ai * 128 + m * 16;
                    if (r >= MROWS) continue;
                    bf16_t* grow = GC + (size_t)r * 512 + (pn - 28) * 256 + cw;
#pragma unroll
                    for (int bj = 0; bj < 2; ++bj) { f32x4 v0 = acc[ai][bj][m][0], v1 = acc[ai][bj][m][1];
#pragma unroll
                        for (int j = 0; j < 4; ++j) { v0[j] = silu_f(v0[j]); v1[j] = silu_f(v1[j]); }
                        u32x4 w; w.x = cvt_pk_bf16(v0[0], v0[1]); w.y = cvt_pk_bf16(v0[2], v0[3]); w.z = cvt_pk_bf16(v1[0], v1[1]); w.w = cvt_pk_bf16(v1[2], v1[3]);
                        *(u32x4*)(grow + bj * 128) = w; }
                }
        }
    }
};
struct EpiOutProj {
    static constexpr bool PERM = false, AFTER_DRAIN = false;
    float* C;
    __device__ __forceinline__ void operator()(const f32x4 (&acc)[2][2][4][2], const pg8::Unit& u, int wr, int wc, int fr, int fq) const {
        const int row0 = u.pm * 256 + wr * 64 + fr, col0 = u.pn * 256 + wc * 32 + 4 * fq;
#pragma unroll
        for (int ai = 0; ai < 2; ++ai)
#pragma unroll
            for (int m = 0; m < 4; ++m) { float* rowp = C + (size_t)(row0 + ai * 128 + m * 16) * DM + col0;
#pragma unroll
                for (int bj = 0; bj < 2; ++bj)
#pragma unroll
                    for (int n = 0; n < 2; ++n) *(f32x4*)(rowp + bj * 128 + n * 16) = acc[ai][bj][m][n]; }
    }
};

constexpr size_t WS_XCH = 41 * MiB + 512 * 1024;
constexpr int CW_PANEL = 8192, CW_SAMPLE = 8192 + 64 * 32;
struct EpiOutFused {
    static constexpr bool PERM = false, AFTER_DRAIN = true;
    const float* x; float* out; const float* g; unsigned* X; unsigned* ctl;
    __device__ __forceinline__ void fused(f32x4 (&acc)[2][2][4][2], const pg8::Unit& u, int wr, int wc, int fr, int fq, LAS unsigned char* lds, int wid, int lane) const {
        LAS float* P = (LAS float*)lds;
        LAS float* S = (LAS float*)(lds + 4096);
        const int tid = wid * 64 + lane;
#pragma unroll
        for (int ai = 0; ai < 2; ++ai)
#pragma unroll
            for (int m = 0; m < 4; ++m) { float s = 0.f;
#pragma unroll
                for (int bj = 0; bj < 2; ++bj)
#pragma unroll
                    for (int n = 0; n < 2; ++n) { const f32x4 v = acc[ai][bj][m][n]; s += (v.x * v.x + v.y * v.y) + (v.z * v.z + v.w * v.w); }
                s += __shfl_xor(s, 16); s += __shfl_xor(s, 32);
                if (fq == 0) P[(ai * 128 + wr * 64 + m * 16 + fr) * 4 + wc] = s; }
        asm volatile("s_waitcnt lgkmcnt(0)" ::: "memory"); __syncthreads();
        unsigned* cnt = ctl + CW_PANEL + 64 * u.pm;
        if (tid < 256) { const f32x4 pv = *(const LAS f32x4*)(P + tid * 4);
            __hip_atomic_store(X + ((size_t)u.pm * 8 + u.pn) * 256 + tid, __float_as_uint((pv.x + pv.y) + (pv.z + pv.w)), __ATOMIC_RELAXED, __HIP_MEMORY_SCOPE_AGENT); }
        asm volatile("s_waitcnt vmcnt(0)" ::: "memory");
        if (wid < 4 && lane == 0) __hip_atomic_fetch_add(cnt, 1u, __ATOMIC_RELAXED, __HIP_MEMORY_SCOPE_AGENT);
        if (wid == 0) { unsigned sp = 0;
            while ((unsigned)__builtin_amdgcn_readfirstlane(__hip_atomic_load(cnt, __ATOMIC_RELAXED, __HIP_MEMORY_SCOPE_AGENT)) < 32u) { __builtin_amdgcn_s_sleep(2); if (++sp > (1u << 20)) break; }
            __builtin_amdgcn_fence(__ATOMIC_ACQUIRE, "agent"); }
        asm volatile("s_waitcnt vmcnt(0) lgkmcnt(0)" ::: "memory"); __syncthreads();
        if (tid < 256) { float t = 0.f;
#pragma unroll
            for (int k = 0; k < 8; ++k) t += __uint_as_float(__hip_atomic_load(X + ((size_t)u.pm * 8 + k) * 256 + tid, __ATOMIC_RELAXED, __HIP_MEMORY_SCOPE_AGENT));
            S[tid] = 1.0f / sqrtf(t * (1.f / DM) + EPS); }
        asm volatile("s_waitcnt lgkmcnt(0)" ::: "memory"); __syncthreads();
        const int col0 = u.pn * 256 + wc * 32 + 4 * fq;
        f32x4 gv[2][2];
#pragma unroll
        for (int bj = 0; bj < 2; ++bj)
#pragma unroll
            for (int n = 0; n < 2; ++n) gv[bj][n] = *(const f32x4*)(g + col0 + bj * 128 + n * 16);
#pragma unroll
        for (int ai = 0; ai < 2; ++ai) {
            f32x4 xv[4][2][2]; float rs[4];
#pragma unroll
            for (int m = 0; m < 4; ++m) { const int r = ai * 128 + wr * 64 + m * 16 + fr; rs[m] = S[r]; const size_t off = (size_t)(u.pm * 256 + r) * DM + col0;
#pragma unroll
                for (int bj = 0; bj < 2; ++bj)
#pragma unroll
                    for (int n = 0; n < 2; ++n) xv[m][bj][n] = __builtin_nontemporal_load((const f32x4*)(x + off + bj * 128 + n * 16)); }
            __builtin_amdgcn_sched_barrier(0);
#pragma unroll
            for (int m = 0; m < 4; ++m) { const int r = ai * 128 + wr * 64 + m * 16 + fr; const size_t off = (size_t)(u.pm * 256 + r) * DM + col0;
#pragma unroll
                for (int bj = 0; bj < 2; ++bj)
#pragma unroll
                    for (int n = 0; n < 2; ++n) __builtin_nontemporal_store(xv[m][bj][n] + acc[ai][bj][m][n] * rs[m] * gv[bj][n], (f32x4*)(out + off + bj * 128 + n * 16)); }
            __builtin_amdgcn_sched_barrier(0);
        }
    }
};

#define KSWZ(row, colB) ((row) * 256 + ((colB) ^ (((row) & 7) << 4)))
__device__ __forceinline__ int crow(int r, int hi) { return (r & 3) + 8 * (r >> 2) + 4 * hi; }
__device__ __forceinline__ int v_st(int k, int c) { const int kk = (k & ~0xC) | ((k & 4) << 1) | ((k & 8) >> 1); return ((kk >> 3) * 4 + (c >> 5)) * 512 + ((kk & 7) * 32 + (c & 31)) * 2; }
__device__ __forceinline__ int v_rd_base(int lane) { return ((lane & 3) << 3) | (((lane >> 2) & 3) << 6) | (((lane >> 4) & 1) << 5) | (((lane >> 5) & 1) << 8); }
constexpr int v_rd_off(int d0, int ks, int half) { return d0 * 512 + ks * 4096 + half * 2048; }
template <int OFF> __device__ __forceinline__ s16x4 tr_read(int vb) {
    s16x4 r; asm volatile("ds_read_b64_tr_b16 %0, %1 offset:%2" : "=&v"(r) : "v"(vb), "i"(OFF) : "memory"); return r;
}
template <int D0> __device__ __forceinline__ void pv_one(f32x16& od, int vb, bf16x8 pa0, bf16x8 pa1) {
    const s16x4 l0 = tr_read<v_rd_off(D0, 0, 0)>(vb), h0 = tr_read<v_rd_off(D0, 0, 1)>(vb), l1 = tr_read<v_rd_off(D0, 1, 0)>(vb), h1 = tr_read<v_rd_off(D0, 1, 1)>(vb);
    asm volatile("s_waitcnt lgkmcnt(0)" ::: "memory"); __builtin_amdgcn_sched_barrier(0);
#define PKV(L, H) (bf16x8){L[0], L[1], L[2], L[3], H[0], H[1], H[2], H[3]}
    od = __builtin_amdgcn_mfma_f32_32x32x16_bf16(pa0, PKV(l0, h0), od, 0, 0, 0);
    od = __builtin_amdgcn_mfma_f32_32x32x16_bf16(pa1, PKV(l1, h1), od, 0, 0, 0);
#undef PKV
}
constexpr float ATT_THR = 8.0f;
__device__ __forceinline__ void attn_tile(const LAS unsigned char* Kt, int vb, const bf16x8 (&qr)[8], const LAS float* tabp, f32x16 (&o)[4], float& m_reg, float& l_reg,
                                          LAS float* al_l, int r32, int hi) {
    f32x16 p = {};
#pragma unroll
    for (int d0 = 0; d0 < 8; ++d0) { const int cb = (d0 * 16 + hi * 8) * 2;
        const bf16x8 kf = *(const LAS bf16x8*)(Kt + KSWZ(r32, cb));
        p = __builtin_amdgcn_mfma_f32_32x32x16_bf16(kf, qr[d0], p, 0, 0, 0); }
#pragma unroll
    for (int r = 0; r < 16; ++r) p[r] += tabp[-(4 * (r & 3) + 32 * (r >> 2))];
    float pmax = p[0];
#pragma unroll
    for (int r = 1; r < 16; ++r) pmax = fmaxf(pmax, p[r]);
    pmax = fmaxf(pmax, __shfl_xor(pmax, 32));
    float mn, alpha;
    if (__all(pmax - m_reg <= ATT_THR)) { mn = m_reg; alpha = 1.f; }
    else { mn = fmaxf(m_reg, pmax); alpha = __builtin_amdgcn_exp2f(m_reg - mn); m_reg = mn; }
    float ps = 0.f;
#pragma unroll
    for (int r = 0; r < 16; ++r) { p[r] = __builtin_amdgcn_exp2f(p[r] - mn); ps += p[r]; }
    ps += __shfl_xor(ps, 32);
    l_reg = l_reg * alpha + ps;
    bf16x8 pa0, pa1;
#define PK4(P, BASE, OUT) do { unsigned a0 = cvt_pk_bf16(P[BASE + 0], P[BASE + 1]), a1 = cvt_pk_bf16(P[BASE + 2], P[BASE + 3]);   \
    unsigned b0 = cvt_pk_bf16(P[BASE + 4], P[BASE + 5]), b1 = cvt_pk_bf16(P[BASE + 6], P[BASE + 7]);                              \
    auto r0 = __builtin_amdgcn_permlane32_swap(a0, b0, false, false); auto r1 = __builtin_amdgcn_permlane32_swap(a1, b1, false, false); \
    u32x4 w = {r0[0], r1[0], r0[1], r1[1]}; OUT = *reinterpret_cast<bf16x8*>(&w); } while (0)
    PK4(p, 0, pa0); PK4(p, 8, pa1);
#undef PK4
    if (__any(alpha < 1.f)) {
        if (hi == 0) al_l[r32] = alpha;
        asm volatile("s_waitcnt lgkmcnt(0)" ::: "memory");
#pragma unroll
        for (int r = 0; r < 16; ++r) { const float a = al_l[crow(r, hi)];
#pragma unroll
            for (int d = 0; d < 4; ++d) o[d][r] *= a; }
    }
    pv_one<0>(o[0], vb, pa0, pa1); pv_one<1>(o[1], vb, pa0, pa1); pv_one<2>(o[2], vb, pa0, pa1); pv_one<3>(o[3], vb, pa0, pa1);
}

__device__ __forceinline__ void attn_prompt_item(const Params& p, LAS unsigned char* lds, int b, int h, int qt) {
    int tid = threadIdx.x; asm volatile("" : "+v"(tid));
    const int wid = __builtin_amdgcn_readfirstlane(tid >> 6), lane = tid & 63, r32 = lane & 31, hi = lane >> 5;
    unsigned char* const wsl = p.ws + opaque0();
    const bf16_t* __restrict__ Z = (const bf16_t*)(wsl + WS_Z);
    bf16_t* __restrict__ MIX = (bf16_t*)(wsl + WS_MIX);
    const int t0 = qt * 256;
    const size_t rowbase = (size_t)b * SEQ;
    LAS float* tab = (LAS float*)(lds + LDS_TAB);
    LAS float* al_l = (LAS float*)(lds + LDS_AL) + wid * 64;
    { const float* tg = (const float*)(wsl + WS_TAB) + h * TAB_N; for (int i = tid; i < TAB_N; i += 512) tab[i] = tg[i]; }
    bf16x8 qr[8];
    { const bf16_t* qp = Z + (rowbase + t0 + 8 * r32 + wid) * LDZ + h * 128 + hi * 8;
#pragma unroll
      for (int d0 = 0; d0 < 8; ++d0) qr[d0] = *(const bf16x8*)(qp + 16 * d0); }
    size_t kofs, vofs;
    { const int rowK = 4 * wid + (lane >> 4), colB = (16 * (lane & 15)) ^ ((rowK & 7) << 4);
      kofs = (size_t)(4 * rowK) * LDZ + 1536 + h * 128 + (colB >> 1);
      const int st = 2 * wid + (lane >> 5), kk = ((st >> 2) << 3) | ((lane & 31) >> 2), k = (kk & ~0xC) | ((kk & 4) << 1) | ((kk & 8) >> 1), cc = 32 * (st & 3) + 8 * (lane & 3);
      vofs = (size_t)(4 * k) * LDZ + 3072 + h * 128 + cc; }
    const bf16_t* zb = Z + rowbase * LDZ;
#define STAGE(c, bsel) do { const bf16_t* g_ = zb + (size_t)(c) * 128 * LDZ; LAS unsigned char* d_ = lds + (bsel) * 65536 + wid * 1024; \
        _Pragma("unroll") for (int g2 = 0; g2 < 4; ++g2) { \
            __builtin_amdgcn_global_load_lds((const unsigned*)(g_ + kofs + (size_t)g2 * LDZ), (LAS unsigned*)(d_ + g2 * 8192), 16, 0, 0); \
            __builtin_amdgcn_global_load_lds((const unsigned*)(g_ + vofs + (size_t)g2 * LDZ), (LAS unsigned*)(d_ + 32768 + g2 * 8192), 16, 0, 0); } } while (0)
    f32x16 o[4] = {}; float m_reg = -1e20f, l_reg = 0.f;
    const int nch = 2 * qt + 2;
    STAGE(0, 0);
    asm volatile("s_waitcnt vmcnt(0)" ::: "memory");
    __syncthreads();
    const int vrb = v_rd_base(lane);
    for (int c = 0; c < nch; ++c) {
        if (c + 1 < nch) STAGE(c + 1, (c + 1) & 1);
        const int bsel = c & 1, p0 = c * 128;
        const bool is_near = (c >= 2 * qt - 1);
        const int tib0 = t0 + 8 * r32 + wid - p0 + TAB_NEG - 16 * hi;
        const LAS unsigned char* kbuf = lds + bsel * 65536;
        const int vbuf = (int)(unsigned)(size_t)(lds + bsel * 65536 + 32768) + vrb;
        if (is_near) {
#pragma unroll 1
            for (int g = 0; g < 4; ++g) attn_tile(kbuf + g * 8192, vbuf + g * 8192, qr, tab + (tib0 - g), o, m_reg, l_reg, al_l, r32, hi);
        } else {
            const int g = wid & 3;
            attn_tile(kbuf + g * 8192, vbuf + g * 8192, qr, tab + (tib0 - g), o, m_reg, l_reg, al_l, r32, hi);
        }
        asm volatile("s_waitcnt vmcnt(0)" ::: "memory");
        __syncthreads();
    }
#undef STAGE
    if (hi == 0) al_l[32 + r32] = l_reg;
    asm volatile("s_waitcnt lgkmcnt(0)" ::: "memory");
    LAS float* ot = (LAS float*)(lds + wid * 16384);
#pragma unroll
    for (int r = 0; r < 16; ++r) { const int qi = crow(r, hi); const float rl = __builtin_amdgcn_rcpf(al_l[32 + qi]);
#pragma unroll
        for (int d0 = 0; d0 < 4; ++d0) ot[qi * 128 + 32 * d0 + r32] = o[d0][r] * rl; }
    asm volatile("s_waitcnt lgkmcnt(0)" ::: "memory");
    {
        u32x4 gv[8];
#pragma unroll
        for (int i = 0; i < 8; ++i) { const int id = lane + 64 * i, row = id >> 4, c8 = id & 15; const size_t m = rowbase + t0 + 8 * row + wid;
            gv[i] = *(const u32x4*)(Z + m * LDZ + 4608 + h * 128 + 8 * c8); }
        __builtin_amdgcn_sched_barrier(0);
#pragma unroll
        for (int i = 0; i < 8; ++i) { const int id = lane + 64 * i, row = id >> 4, c8 = id & 15; const size_t m = rowbase + t0 + 8 * row + wid;
            const f32x4 x0 = *(const LAS f32x4*)(ot + row * 128 + 8 * c8), x1 = *(const LAS f32x4*)(ot + row * 128 + 8 * c8 + 4);
            u32x4 w;
            w.x = cvt_pk_bf16(x0.x * __uint_as_float(gv[i].x << 16), x0.y * __uint_as_float(gv[i].x & 0xffff0000u));
            w.y = cvt_pk_bf16(x0.z * __uint_as_float(gv[i].y << 16), x0.w * __uint_as_float(gv[i].y & 0xffff0000u));
            w.z = cvt_pk_bf16(x1.x * __uint_as_float(gv[i].z << 16), x1.y * __uint_as_float(gv[i].z & 0xffff0000u));
            w.w = cvt_pk_bf16(x1.z * __uint_as_float(gv[i].w << 16), x1.w * __uint_as_float(gv[i].w & 0xffff0000u));
            *(u32x4*)(MIX + m * DM + h * 128 + 8 * c8) = w; }
    }
    __syncthreads();
}

template <int N> __device__ __forceinline__ float dpp_ror_add(float x) {
    return x + __int_as_float(__builtin_amdgcn_update_dpp(0, __float_as_int(x), 0x120 + N, 0xf, 0xf, false));
}
__device__ __forceinline__ float row_allsum16(float x) { x = dpp_ror_add<8>(x); x = dpp_ror_add<4>(x); x = dpp_ror_add<2>(x); x = dpp_ror_add<1>(x); return x; }
__device__ __forceinline__ void attn_sample_item(const Params& p, LAS unsigned char* lds, int b, int h) {
    int tid = threadIdx.x; asm volatile("" : "+v"(tid));
    const int g = tid >> 4, l16 = tid & 15;
    const size_t oz = opaque0();
    unsigned char* const wsl = p.ws + oz; float* const outl = p.out + oz; const float* const ckv = p.in[3] + oz;
    const bf16_t* __restrict__ Z = (const bf16_t*)(wsl + WS_Z);
    bf16_t* __restrict__ MIX = (bf16_t*)(wsl + WS_MIX);
    LAS float* mo = (LAS float*)lds;
    LAS float* ml = (LAS float*)(lds + 65536);
    LAS float* tab = (LAS float*)(lds + LDS_TAB);
    { const float* tg = (const float*)(wsl + WS_TAB) + h * TAB_N; for (int i = tid; i < TAB_N; i += 512) tab[i] = tg[i]; }
    float q[4][8];
#pragma unroll
    for (int j = 0; j < 4; ++j) { const bf16_t* qp = Z + (size_t)(NPR + b * 4 + j) * LDZ + h * 128 + 4 * l16;
        const u32x2 w0 = *(const u32x2*)qp, w1 = *(const u32x2*)(qp + 64);
        q[j][0] = __uint_as_float(w0.x << 16); q[j][1] = __uint_as_float(w0.x & 0xffff0000u); q[j][2] = __uint_as_float(w0.y << 16); q[j][3] = __uint_as_float(w0.y & 0xffff0000u);
        q[j][4] = __uint_as_float(w1.x << 16); q[j][5] = __uint_as_float(w1.x & 0xffff0000u); q[j][6] = __uint_as_float(w1.y << 16); q[j][7] = __uint_as_float(w1.y & 0xffff0000u); }
    const float* __restrict__ ck = ckv + (size_t)b * 2048 * 3072 + h * 128 + 4 * l16;
    const float* __restrict__ nk = outl + O_KVS + (size_t)b * 2048 * 3072 + h * 128 + 4 * l16;
    float* nkw = outl + O_KVS + (size_t)b * 2048 * 3072 + h * 128 + 4 * l16;
    float m_[4], l_[4], o[4][8];
#pragma unroll
    for (int j = 0; j < 4; ++j) { m_[j] = -1e20f; l_[j] = 0.f;
#pragma unroll
        for (int d = 0; d < 8; ++d) o[j][d] = 0.f; }
    __syncthreads();
#define SA_ROWS(NR, KA, KB, VA, VB, SS) do { \
        float sc_[NR][4]; \
        _Pragma("unroll") for (int u = 0; u < NR; ++u) _Pragma("unroll") for (int j = 0; j < 4; ++j) { \
            float d = q[j][0] * KA[u].x + q[j][1] * KA[u].y + q[j][2] * KA[u].z + q[j][3] * KA[u].w + q[j][4] * KB[u].x + q[j][5] * KB[u].y + q[j][6] * KB[u].z + q[j][7] * KB[u].w; \
            sc_[u][j] = row_allsum16(d) + tab[2048 + TAB_NEG + j - SS[u]]; } \
        _Pragma("unroll") for (int j = 0; j < 4; ++j) { float mx = sc_[0][j]; _Pragma("unroll") for (int u = 1; u < NR; ++u) mx = fmaxf(mx, sc_[u][j]); \
            const float mn = fmaxf(m_[j], mx), al = __builtin_amdgcn_exp2f(m_[j] - mn); m_[j] = mn; l_[j] *= al; \
            _Pragma("unroll") for (int d = 0; d < 8; ++d) o[j][d] *= al; \
            _Pragma("unroll") for (int u = 0; u < NR; ++u) { const float pe = __builtin_amdgcn_exp2f(sc_[u][j] - mn); l_[j] += pe; \
                o[j][0] += pe * VA[u].x; o[j][1] += pe * VA[u].y; o[j][2] += pe * VA[u].z; o[j][3] += pe * VA[u].w; \
                o[j][4] += pe * VB[u].x; o[j][5] += pe * VB[u].y; o[j][6] += pe * VB[u].z; o[j][7] += pe * VB[u].w; } } } while (0)
#pragma unroll 1
    for (int kb = 0; kb < 7; ++kb) {
        f32x4 ka[4], kc[4], va[4], vc[4]; int ss[4];
#pragma unroll
        for (int u = 0; u < 4; ++u) { const int n = g + 32 * (kb * 4 + u); ss[u] = n < 384 ? ((n >> 2) << 4) + (n & 3) : n + 1152;
            const float* rp = ck + (size_t)ss[u] * 3072;
            ka[u] = __builtin_nontemporal_load((const f32x4*)rp); kc[u] = __builtin_nontemporal_load((const f32x4*)(rp + 64)); va[u] = __builtin_nontemporal_load((const f32x4*)(rp + 1536)); vc[u] = __builtin_nontemporal_load((const f32x4*)(rp + 1600)); }
        __builtin_amdgcn_sched_barrier(0);
        SA_ROWS(4, ka, kc, va, vc, ss);
#pragma unroll
        for (int u = 0; u < 4; ++u) asm volatile("" :: "v"(ka[u]), "v"(kc[u]), "v"(va[u]), "v"(vc[u]));
        __builtin_amdgcn_sched_barrier(0);
#pragma unroll
        for (int u = 0; u < 4; ++u) if (ss[u] >= 4) {
            float* wp = nkw + (size_t)(ss[u] - 4) * 3072;
            st16_hidden_nt(wp, ka[u]); st16_hidden_nt(wp + 64, kc[u]); st16_hidden_nt(wp + 1536, va[u]); st16_hidden_nt(wp + 1600, vc[u]); }
#pragma unroll
        for (int u = 0; u < 4; ++u) asm volatile("" :: "v"(ka[u]), "v"(kc[u]), "v"(va[u]), "v"(vc[u]));
    }
    if (g < 4) {
        f32x4 ka[1], kc[1], va[1], vc[1]; int ss[1]; ss[0] = 2048 + g;
        const float* rp = nk + (size_t)(2044 + g) * 3072;
        ka[0] = *(const f32x4*)rp; kc[0] = *(const f32x4*)(rp + 64); va[0] = *(const f32x4*)(rp + 1536); vc[0] = *(const f32x4*)(rp + 1600);
        SA_ROWS(1, ka, kc, va, vc, ss);
    }
#undef SA_ROWS
#pragma unroll
    for (int j = 0; j < 4; ++j) { LAS float* op = mo + (g * 4 + j) * 128 + 4 * l16;
        *(LAS f32x4*)op = (f32x4){o[j][0], o[j][1], o[j][2], o[j][3]}; *(LAS f32x4*)(op + 64) = (f32x4){o[j][4], o[j][5], o[j][6], o[j][7]};
        if (l16 == 0) { ml[(g * 4 + j) * 2] = m_[j]; ml[(g * 4 + j) * 2 + 1] = l_[j]; } }
    __syncthreads();
    { const int j = tid >> 7, dh = tid & 127; float M = -1e20f;
#pragma unroll 8
      for (int k = 0; k < 32; ++k) M = fmaxf(M, ml[(k * 4 + j) * 2]);
      float num = 0.f, den = 0.f;
#pragma unroll 8
      for (int k = 0; k < 32; ++k) { const float wgt = __builtin_amdgcn_exp2f(ml[(k * 4 + j) * 2] - M); num += wgt * mo[(k * 4 + j) * 128 + dh]; den += wgt * ml[(k * 4 + j) * 2 + 1]; }
      const size_t m = (size_t)NPR + b * 4 + j;
      MIX[m * DM + h * 128 + dh] = f2bf(num / den * bf2f(Z[m * LDZ + 4608 + h * 128 + dh])); }
    __syncthreads();
}

__device__ __forceinline__ void conv_item(const Params& p, LAS unsigned char* lds, int tile, const int stages = 7) {
    int tid = threadIdx.x; asm volatile("" : "+v"(tid));
    const int wid = __builtin_amdgcn_readfirstlane(tid >> 6), lane = tid & 63, r32 = lane & 31, hi = lane >> 5;
    LAS float* cbuf = (LAS float*)lds;
    const size_t oz = opaque0();
    unsigned char* const wsl = p.ws + oz;
    const float* const dww = p.in[7] + oz; const float* const dwb = p.in[8] + oz; const float* const lng = p.in[9] + oz; const float* const lnb = p.in[10] + oz; const float* const pwb = p.in[12] + oz;
    const bf16_t* __restrict__ GC = (const bf16_t*)(wsl + WS_GC);
    bf16_t* __restrict__ MIX = (bf16_t*)(wsl + WS_MIX);
    size_t mbase = 0;
    if (stages & 1)
    {
        typedef float f32x2 __attribute__((ext_vector_type(2)));
        const int cp = tid & 255, th = tid >> 8;
        f32x2 w[31];
#pragma unroll
        for (int j = 0; j < 31; ++j) w[j] = *(const f32x2*)(dww + j * 512 + 2 * cp);
        const f32x2 bias = *(const f32x2*)(dwb + 2 * cp);
#define CV_UNPACK(u) ((f32x2){__uint_as_float((u) << 16), __uint_as_float((u) & 0xffff0000u)})
        if (tile < 128) {
            const int b = tile >> 5, t0 = (tile & 31) * 64; mbase = (size_t)b * SEQ + t0;
            const unsigned* __restrict__ up = (const unsigned*)((const bf16_t*)(wsl + WS_UPP) + ((size_t)b * 2078 + t0 + 32 * th) * 512) + cp;
            unsigned raw[38];
#pragma unroll
            for (int i = 0; i < 38; ++i) raw[i] = up[(size_t)i * 256];
            __builtin_amdgcn_sched_barrier(0);
            f32x2 win[38];
#pragma unroll
            for (int i = 0; i < 38; ++i) win[i] = CV_UNPACK(raw[i]);
#pragma unroll 1
            for (int g = 0; g < 4; ++g) {
                unsigned nx[8];
                const unsigned* un = up + (size_t)(8 * (g < 3 ? g + 1 : g) + 30) * 256;
#pragma unroll
                for (int i = 0; i < 8; ++i) nx[i] = un[(size_t)i * 256];
                __builtin_amdgcn_sched_barrier(0);
#pragma unroll
                for (int o = 0; o < 8; ++o) { f32x2 a = bias;
#pragma unroll
                    for (int j = 0; j < 31; ++j) a += w[j] * win[o + j];
                    *(LAS f32x2*)(cbuf + (32 * th + 8 * g + o) * 512 + 2 * cp) = a; }
#pragma unroll
                for (int i = 0; i < 30; ++i) win[i] = win[i + 8];
#pragma unroll
                for (int i = 0; i < 8; ++i) win[30 + i] = CV_UNPACK(nx[i]);
            }
        } else {
            const int bb0 = (tile - 128) * 16; mbase = (size_t)NPR + bb0 * 4;
            const unsigned* __restrict__ up = (const unsigned*)((const bf16_t*)(wsl + WS_UPS) + (size_t)(bb0 + 8 * th) * 34 * 512) + cp;
            unsigned raw[34];
#pragma unroll
            for (int i = 0; i < 34; ++i) raw[i] = up[(size_t)i * 256];
#pragma unroll 1
            for (int bb = 0; bb < 8; ++bb) {
                f32x2 win[34];
#pragma unroll
                for (int i = 0; i < 34; ++i) win[i] = CV_UNPACK(raw[i]);
                const unsigned* un = up + (size_t)((bb < 7 ? bb + 1 : bb) * 34) * 256;
#pragma unroll
                for (int i = 0; i < 34; ++i) raw[i] = un[(size_t)i * 256];
                __builtin_amdgcn_sched_barrier(0);
#pragma unroll
                for (int o = 0; o < 4; ++o) { f32x2 a = bias;
#pragma unroll
                    for (int j = 0; j < 31; ++j) a += w[j] * win[o + j];
                    *(LAS f32x2*)(cbuf + ((8 * th + bb) * 4 + o) * 512 + 2 * cp) = a; }
            }
        }
#undef CV_UNPACK
    }
    __syncthreads();
    if (stages & 2)
    {
        const f32x4 g0 = *(const f32x4*)(lng + 8 * lane), g1 = *(const f32x4*)(lng + 8 * lane + 4);
        const f32x4 b0 = *(const f32x4*)(lnb + 8 * lane), b1 = *(const f32x4*)(lnb + 8 * lane + 4);
#pragma unroll 1
        for (int tk = 0; tk < 8; ++tk) {
            const int row = 8 * wid + tk;
            f32x4 x0 = *(const LAS f32x4*)(cbuf + row * 512 + 8 * lane), x1 = *(const LAS f32x4*)(cbuf + row * 512 + 8 * lane + 4);
            const float mu = wave_sum((x0.x + x0.y) + (x0.z + x0.w) + (x1.x + x1.y) + (x1.z + x1.w)) * (1.f / 512.f);
            x0 = x0 - mu; x1 = x1 - mu;
            const float var = wave_sum((x0.x * x0.x + x0.y * x0.y) + (x0.z * x0.z + x0.w * x0.w) + (x1.x * x1.x + x1.y * x1.y) + (x1.z * x1.z + x1.w * x1.w)) * (1.f / 512.f);
            const float rstd = 1.0f / sqrtf(var + EPS);
            x0 = x0 * rstd * g0 + b0; x1 = x1 * rstd * g1 + b1;
#pragma unroll
            for (int j = 0; j < 4; ++j) { x0[j] = silu_f(x0[j]); x1[j] = silu_f(x1[j]); }
            u32x4 wv; wv.x = cvt_pk_bf16(x0[0], x0[1]); wv.y = cvt_pk_bf16(x0[2], x0[3]); wv.z = cvt_pk_bf16(x1[0], x1[1]); wv.w = cvt_pk_bf16(x1[2], x1[3]);
            *(LAS u32x4*)((LAS unsigned char*)cbuf + row * 2048 + ((lane ^ (row & 15)) << 4)) = wv;
        }
    }
    __syncthreads();
    if (stages & 4)
    {
        const bf16_t* __restrict__ WT = (const bf16_t*)(wsl + WS_WPW);
        const bf16_t* wp0 = WT + (size_t)(64 * wid + r32) * 512 + 8 * hi; const bf16_t* wp1 = wp0 + 32 * 512;
        const LAS unsigned char* ab = (const LAS unsigned char*)cbuf;
        f32x16 acc[2][2] = {};
#pragma unroll 1
        for (int s8 = 0; s8 < 32; s8 += 8) {
            bf16x8 bf0[8], bf1[8];
#pragma unroll
            for (int u = 0; u < 8; ++u) { bf0[u] = *(const bf16x8*)(wp0 + 16 * (s8 + u)); bf1[u] = *(const bf16x8*)(wp1 + 16 * (s8 + u)); }
            __builtin_amdgcn_sched_barrier(0);
#pragma unroll
            for (int u = 0; u < 8; ++u) { const int s = s8 + u;
                const bf16x8 a0 = *(const LAS bf16x8*)(ab + r32 * 2048 + (((2 * s + hi) ^ (r32 & 15)) << 4));
                const bf16x8 a1 = *(const LAS bf16x8*)(ab + (32 + r32) * 2048 + (((2 * s + hi) ^ (r32 & 15)) << 4));
                acc[0][0] = __builtin_amdgcn_mfma_f32_32x32x16_bf16(a0, bf0[u], acc[0][0], 0, 0, 0);
                acc[0][1] = __builtin_amdgcn_mfma_f32_32x32x16_bf16(a0, bf1[u], acc[0][1], 0, 0, 0);
                acc[1][0] = __builtin_amdgcn_mfma_f32_32x32x16_bf16(a1, bf0[u], acc[1][0], 0, 0, 0);
                acc[1][1] = __builtin_amdgcn_mfma_f32_32x32x16_bf16(a1, bf1[u], acc[1][1], 0, 0, 0); }
        }
        __syncthreads();
#pragma unroll
        for (int ct = 0; ct < 2; ++ct) { const int e = 64 * wid + 32 * ct + r32; const float pb = pwb[e];
#pragma unroll
            for (int rt = 0; rt < 2; ++rt)
#pragma unroll
                for (int r = 0; r < 16; ++r) cbuf[(32 * rt + crow(r, hi)) * 512 + e] = acc[rt][ct][r] + pb; }
        __syncthreads();
        u32x4 gv[8];
#pragma unroll
        for (int i = 0; i < 8; ++i) { const int id = tid + 512 * i, row = id >> 6, c8 = id & 63; gv[i] = *(const u32x4*)(GC + (mbase + row) * 512 + 8 * c8); }
        __builtin_amdgcn_sched_barrier(0);
#pragma unroll
        for (int i = 0; i < 8; ++i) { const int id = tid + 512 * i, row = id >> 6, c8 = id & 63;
            const f32x4 x0 = *(const LAS f32x4*)(cbuf + row * 512 + 8 * c8), x1 = *(const LAS f32x4*)(cbuf + row * 512 + 8 * c8 + 4);
            u32x4 wv;
            wv.x = cvt_pk_bf16(x0.x * __uint_as_float(gv[i].x << 16), x0.y * __uint_as_float(gv[i].x & 0xffff0000u));
            wv.y = cvt_pk_bf16(x0.z * __uint_as_float(gv[i].y << 16), x0.w * __uint_as_float(gv[i].y & 0xffff0000u));
            wv.z = cvt_pk_bf16(x1.x * __uint_as_float(gv[i].z << 16), x1.y * __uint_as_float(gv[i].z & 0xffff0000u));
            wv.w = cvt_pk_bf16(x1.z * __uint_as_float(gv[i].w << 16), x1.w * __uint_as_float(gv[i].w & 0xffff0000u));
            *(u32x4*)(MIX + (mbase + row) * DM + 1536 + 8 * c8) = wv; }
    }
    __syncthreads();
}

constexpr int N_PA = 384, N_SA = 384, N_CV = 130, N_ITEMS = N_PA + N_SA + N_CV;
__device__ __forceinline__ void p2_phase(const Params& p, LAS unsigned char* lds, const int mask = 7) {
    unsigned* head = (unsigned*)(p.ws + WS_CTL) + 64;
    volatile LAS int* slot = (volatile LAS int*)(lds + LDS_MISC);
    unsigned* donec = (unsigned*)(p.ws + WS_CTL) + 128;
    unsigned prev = 0u;
    for (;;) {
        if (threadIdx.x == 0) { if (prev) atomicAdd(donec, prev); slot[0] = (int)atomicAdd(head, 1u); }
        prev = 1u;
        __syncthreads();
        const int it = __builtin_amdgcn_readfirstlane(slot[0]);
        __syncthreads();
        if (it >= N_ITEMS) break;
        if (it < N_CV) { if (mask & 4) conv_item(p, lds, it); }
        else {
            const int j = it - N_CV; int pa = -1, sa = -1;
            if (j < 192) { if (j & 1) sa = j >> 1; else pa = j >> 1; }
            else if (j < 192 + 432) { const int r = j - 192, t3 = r / 3, m3 = r % 3; if (m3 == 2) pa = 96 + t3; else sa = 96 + 2 * t3 + m3; }
            else pa = 240 + (j - 624);
            if (pa >= 0) { const int qt = 7 - pa / 48, rem = pa % 48; if (mask & 1) attn_prompt_item(p, lds, rem / 12, rem % 12, qt); }
            else { if (mask & 2) attn_sample_item(p, lds, sa / 12, sa % 12); } }
    }
    unsigned* phead = (unsigned*)(p.ws + WS_CTL) + 192;
    for (;;) {
        __syncthreads();
        if (threadIdx.x == 0) slot[0] = (__hip_atomic_load(donec, __ATOMIC_RELAXED, __HIP_MEMORY_SCOPE_AGENT) >= (unsigned)N_ITEMS) ? CP_POOL : (int)atomicAdd(phead, 1u);
        __syncthreads();
        const int q = __builtin_amdgcn_readfirstlane(slot[0]);
        if (q >= CP_POOL) break;
        CopyBurst cb; cb.init(p.in[3], p.out + O_KVS, 0); cb.burst(q / (12 - CP_STATIC), CP_STATIC + q % (12 - CP_STATIC), CP_STATIC + q % (12 - CP_STATIC) + 1);
    }
}

__device__ __forceinline__ void pool_idle(const Params& p, LAS unsigned char* lds, const int cw, const unsigned total) {
    unsigned* donec = (unsigned*)(p.ws + WS_CTL) + cw;
    unsigned* phead = (unsigned*)(p.ws + WS_CTL) + 192;
    volatile LAS int* slot = (volatile LAS int*)(lds + LDS_MISC);
    unsigned first = 1u;
    for (;;) {
        __syncthreads();
        if (threadIdx.x == 0) { if (first) atomicAdd(donec, 1u);
            slot[0] = (__hip_atomic_load(donec, __ATOMIC_RELAXED, __HIP_MEMORY_SCOPE_AGENT) >= total) ? CP_POOL : (int)atomicAdd(phead, 1u); }
        first = 0u;
        __syncthreads();
        const int q = __builtin_amdgcn_readfirstlane(slot[0]);
        if (q >= CP_POOL) break;
        CopyBurst cb; cb.init(p.in[3], p.out + O_KVS, 0); cb.burst(q / (12 - CP_STATIC), CP_STATIC + q % (12 - CP_STATIC), CP_STATIC + q % (12 - CP_STATIC) + 1);
    }
}

__device__ __forceinline__ void pool_drain(const Params& p, LAS unsigned char* lds, const int quota) {
    unsigned* head = (unsigned*)(p.ws + WS_CTL) + 192;
    volatile LAS int* slot = (volatile LAS int*)(lds + LDS_MISC);
    for (int n = 0; n < quota; ++n) {
        __syncthreads();
        if (threadIdx.x == 0) slot[0] = (int)atomicAdd(head, 1u);
        __syncthreads();
        const int q = __builtin_amdgcn_readfirstlane(slot[0]);
        if (q >= CP_POOL) break;
        CopyBurst cb; cb.init(p.in[3], p.out + O_KVS, 0); cb.burst(q / (12 - CP_STATIC), CP_STATIC + q % (12 - CP_STATIC), CP_STATIC + q % (12 - CP_STATIC) + 1);
    }
}

__device__ __forceinline__ void sample_slice(const Params& p, LAS unsigned char* lds) {
    const int blk = blockIdx.x;
    const int tid = threadIdx.x, wid = tid >> 6, lane = tid & 63, l15 = lane & 15, kg = lane >> 4;
    float* __restrict__ Y = (float*)(p.ws + WS_Y);
    unsigned* cnt = (unsigned*)(p.ws + WS_CTL) + CW_SAMPLE;
    const int ncol = 8 * blk + l15;
    const bf16_t* __restrict__ A = (const bf16_t*)(p.ws + WS_MIX) + (size_t)(NPR + l15) * DM + 256 * wid + 8 * kg;
    const bf16_t* __restrict__ B = (const bf16_t*)(p.ws + WS_WOUT) + (size_t)(ncol < DM ? ncol : DM - 1) * DM + 256 * wid + 8 * kg;
    bf16x8 bq[8];
#pragma unroll
    for (int s = 0; s < 8; ++s) bq[s] = *(const bf16x8*)(B + 32 * s);
    LAS float* part = (LAS float*)lds + wid * 2048;
#pragma unroll 1
    for (int h2 = 0; h2 < 2; ++h2) {
        bf16x8 a[4][8];
#pragma unroll
        for (int rt = 0; rt < 4; ++rt)
#pragma unroll
            for (int s = 0; s < 8; ++s) a[rt][s] = *(const bf16x8*)(A + (size_t)(16 * (4 * h2 + rt)) * DM + 32 * s);
        __builtin_amdgcn_sched_barrier(0);
#pragma unroll
        for (int rt = 0; rt < 4; ++rt) { f32x4 acc = {0.f, 0.f, 0.f, 0.f};
#pragma unroll
            for (int s = 0; s < 8; ++s) acc = __builtin_amdgcn_mfma_f32_16x16x32_bf16(a[rt][s], bq[s], acc, 0, 0, 0);
#pragma unroll
            for (int r = 0; r < 4; ++r) part[(16 * (4 * h2 + rt) + 4 * kg + r) * 16 + l15] = acc[r]; }
    }
    __syncthreads();
#pragma unroll
    for (int i = 0; i < 2; ++i) { const int o = tid + 512 * i, row = o >> 3, c = o & 7; float sum = 0.f;
#pragma unroll
        for (int w = 0; w < 8; ++w) sum += ((LAS float*)lds)[w * 2048 + row * 16 + c];
        Y[(size_t)(NPR + row) * DM + 8 * blk + c] = sum; }
    asm volatile("s_waitcnt vmcnt(0)" ::: "memory");
    __syncthreads();
    if (tid == 0) { __builtin_amdgcn_fence(__ATOMIC_RELEASE, "agent"); asm volatile("s_waitcnt vmcnt(0)" ::: "memory");
        __hip_atomic_fetch_add(cnt, 1u, __ATOMIC_RELAXED, __HIP_MEMORY_SCOPE_AGENT); }
}
__device__ __forceinline__ void sample_final(const Params& p) {
    const int blk = blockIdx.x, tid = threadIdx.x, wid = tid >> 6, lane = tid & 63;
    if (blk >= 128 || wid != 0) return;
    const float* __restrict__ Y = (const float*)(p.ws + WS_Y);
    unsigned* cnt = (unsigned*)(p.ws + WS_CTL) + CW_SAMPLE;
    const int i = blk; unsigned sp = 0;
    while ((unsigned)__builtin_amdgcn_readfirstlane(__hip_atomic_load(cnt, __ATOMIC_RELAXED, __HIP_MEMORY_SCOPE_AGENT)) < gridDim.x) { __builtin_amdgcn_s_sleep(4); if (++sp > (1u << 20)) break; }
    __builtin_amdgcn_fence(__ATOMIC_ACQUIRE, "agent");
    asm volatile("s_waitcnt vmcnt(0)" ::: "memory");
    const f32x4* yr = (const f32x4*)(Y + (size_t)(NPR + i) * DM) + lane;
    const f32x4* xr = (const f32x4*)(p.in[1] + (size_t)i * DM) + lane;
    const f32x4* gp = (const f32x4*)p.in[14] + lane;
    f32x4* orow = (f32x4*)(p.out + O_YS + (size_t)i * DM) + lane;
    f32x4 v[8]; float s = 0.f;
#pragma unroll
    for (int j = 0; j < 8; ++j) { v[j] = yr[64 * j]; s += (v[j].x * v[j].x + v[j].y * v[j].y) + (v[j].z * v[j].z + v[j].w * v[j].w); }
    const float rstd = 1.0f / sqrtf(wave_sum(s) * (1.f / DM) + EPS);
#pragma unroll
    for (int j = 0; j < 8; ++j) orow[64 * j] = xr[64 * j] + v[j] * rstd * gp[64 * j];
}

__device__ __forceinline__ void p4_final(const Params& p) {
    const int tid = threadIdx.x, lane = tid & 63, wave = tid >> 6;
    const int gw = blockIdx.x * 8 + wave, NGW = gridDim.x * 8;
    const float* Y = (const float*)(p.ws + WS_Y);
    const f32x4* gp = (const f32x4*)p.in[14] + lane;
    for (int m = gw; m < MROWS; m += NGW) {
        const f32x4* yr = (const f32x4*)(Y + (size_t)m * DM) + lane;
        const f32x4* xr = (const f32x4*)(m < NPR ? p.in[0] + (size_t)m * DM : p.in[1] + (size_t)(m - NPR) * DM) + lane;
        f32x4* orow = (f32x4*)(m < NPR ? p.out + O_YP + (size_t)m * DM : p.out + O_YS + (size_t)(m - NPR) * DM) + lane;
        f32x4 v[8]; float s = 0.f;
#pragma unroll
        for (int j = 0; j < 8; ++j) { v[j] = yr[64 * j]; s += (v[j].x * v[j].x + v[j].y * v[j].y) + (v[j].z * v[j].z + v[j].w * v[j].w); }
        const float rstd = 1.0f / sqrtf(wave_sum(s) * (1.f / DM) + EPS);
#pragma unroll
        for (int j = 0; j < 8; ++j) orow[64 * j] = xr[64 * j] + v[j] * rstd * gp[64 * j];
    }
}

__global__ void __launch_bounds__(512, 2) mega_fwd(Params p) {
    extern __shared__ __attribute__((aligned(16))) unsigned char lds_raw[];
    LAS unsigned char* lds = (LAS unsigned char*)lds_raw;
    const int lo = p.ph_lo, hi = p.ph_hi;
    if (threadIdx.x < 64) ((LAS unsigned*)(lds + LDS_MISC))[threadIdx.x] = 0u;
    __syncthreads();
    unsigned long long ts0 = 0, ts1 = 0;
    if (PROBE_T == 100) ts0 = __builtin_amdgcn_s_memrealtime();
#define TSTAMP(k) do { if (PROBE_T == (k)) ts0 = __builtin_amdgcn_s_memrealtime(); if (PROBE_T == (k) - 1 && PROBE_T > 0) ts1 = __builtin_amdgcn_s_memrealtime(); } while (0)
    XcdBarrier bar = xcd_barrier_post((unsigned*)(p.ws + WS_CTL) + 1024, (volatile LAS unsigned*)(lds + LDS_MISC) + 8);
#define IN(k) (lo <= (k) && (k) < hi)
#define SEAM(k) do { if (IN(k) && IN((k) + 1)) xcd_barrier(bar); } while (0)
    TSTAMP(1);
    if (PROBE_T == 100) ts1 = __builtin_amdgcn_s_memrealtime();
#ifndef SKIP_P0
    if (IN(0)) p0_prologue(p, lds);
    if (PROBE_DUP == 0) { xcd_barrier(bar); p0_prologue(p, lds); }
#endif
    SEAM(0);
    TSTAMP(2);
#ifndef SKIP_P1
    if (IN(1)) {
        pg8::Gemm g{(const bf16_t*)(p.ws + WS_H), (const bf16_t*)(p.ws + WS_WIN), MPAD, DIN, DM};
        pg8::StaticOrder S; S.init(MPAD, DIN, (int)gridDim.x, (int)blockIdx.x);
        EpiInProj E{(bf16_t*)(p.ws + WS_Z), (bf16_t*)(p.ws + WS_GC), (bf16_t*)(p.ws + WS_UPP), (bf16_t*)(p.ws + WS_UPS), p.out};
        CopyBurst rider; rider.init(p.in[3], p.out + O_KVS, (int)(blockIdx.x >> 3) & 3);
        pg8::gemm_phase<EpiInProj, pg8::StaticOrder, CopyBurst, false>(lds, g, S, E, rider, nullptr);
        rider.finish();
        pool_idle(p, lds, 130, 256u);
    }
#endif
    SEAM(1);
    TSTAMP(3);
#ifndef SKIP_P2
    if (IN(2)) p2_phase(p, lds);
    if (PROBE_DUP == 2) { xcd_barrier(bar); if (blockIdx.x == 0 && threadIdx.x == 0) *((volatile unsigned*)(p.ws + WS_CTL) + 64) = 0u; __threadfence(); xcd_barrier(bar); p2_phase(p, lds, PROBE_MASK); }
#endif
    SEAM(2);
    TSTAMP(4);
#ifndef SKIP_P3
    if (IN(3)) {
        pg8::Gemm g{(const bf16_t*)(p.ws + WS_MIX), (const bf16_t*)(p.ws + WS_WOUT), NPR, DM, DM};
        pg8::StaticOrder S; S.init(NPR, DM, (int)gridDim.x, (int)blockIdx.x);
        EpiOutFused E{p.in[0], p.out + O_YP, p.in[14], (unsigned*)(p.ws + WS_XCH), (unsigned*)(p.ws + WS_CTL)};
        NoRider rider;
        if ((blockIdx.x >> 3) & 1) pool_drain(p, lds, POOL_FIRST);
        sample_slice(p, lds);
        __syncthreads();
        pg8::gemm_phase<EpiOutFused, pg8::StaticOrder, NoRider, false>(lds, g, S, E, rider, nullptr);
        sample_final(p);
        pool_drain(p, lds, CP_POOL);
    }
#endif
    TSTAMP(5);
    TSTAMP(6);
    if (PROBE_T > 0 && blockIdx.x == 0 && threadIdx.x == 0) { const unsigned long long d = ts1 - ts0, t = __builtin_amdgcn_s_memrealtime(); while (__builtin_amdgcn_s_memrealtime() - t < d) __builtin_amdgcn_s_sleep(4); }
#undef IN
#undef SEAM
}

extern "C" void kernel_launch(void* const* d_in, const int* in_sizes, int n_in, void* d_out, int out_size, void* d_ws, size_t ws_size, hipStream_t stream) {
    static int grid = 0;
    if (grid == 0) {
        if (n_in != 15 || out_size != 244084736 || ws_size < WS_END) { fprintf(stderr, "kernel_launch: unexpected shapes (n_in %d out %d ws %zu)\n", n_in, out_size, ws_size); grid = -1; return; }
        int dev = 0, cus = 0, per_cu = 0;
        hipGetDevice(&dev); hipDeviceGetAttribute(&cus, hipDeviceAttributeMultiprocessorCount, dev);
        if (hipFuncSetAttribute((const void*)mega_fwd, hipFuncAttributeMaxDynamicSharedMemorySize, LDS_BYTES) != hipSuccess) { fprintf(stderr, "kernel_launch: hipFuncSetAttribute failed\n"); grid = -1; return; }
        hipOccupancyMaxActiveBlocksPerMultiprocessor(&per_cu, (const void*)mega_fwd, 512, LDS_BYTES);
        if (per_cu < 1) { fprintf(stderr, "kernel_launch: occupancy query says %d blocks/CU\n", per_cu); grid = -1; return; }
        if (cus < 256) { fprintf(stderr, "kernel_launch: built for a 256-CU device (got %d CUs)\n", cus); grid = -1; return; }
        grid = 256;
    }
    if (grid < 0) return;
    hipMemsetAsync((char*)d_ws + WS_CTL, 0, CTL_BYTES, stream);
    Params prm{};
    for (int i = 0; i < 15; ++i) prm.in[i] = (const float*)d_in[i];
    prm.out = (float*)d_out; prm.ws = (unsigned char*)d_ws;
#if MK_N_LAUNCHES == 1
    prm.ph_lo = 0; prm.ph_hi = 5;
    void* args[] = {&prm};
    hipError_t e = hipLaunchCooperativeKernel((const void*)mega_fwd, dim3(grid), dim3(512), args, LDS_BYTES, stream);
    if (e != hipSuccess) fprintf(stderr, "cooperative launch failed: %s (grid %d)\n", hipGetErrorString(e), grid);
#else
    for (int ph = 0; ph < 5; ++ph) { prm.ph_lo = ph; prm.ph_hi = ph + 1; hipLaunchKernelGGL(mega_fwd, dim3(grid), dim3(512), LDS_BYTES, stream, prm); }
#endif
}
```

```cpp
#include <hip/hip_runtime.h>
#include <hip/hip_cooperative_groups.h>
#include <cstdio>
#include <cstdint>
namespace cg = cooperative_groups;
#ifndef PROBE_MASK
#define PROBE_MASK 7
#endif
#ifndef PROBE_REP
#define PROBE_REP 0
#endif
#ifndef PROBE_CVS
#define PROBE_CVS 0
#endif
#ifndef PROBE_T
#define PROBE_T 0
#endif
#ifndef PROBE_RL
#define PROBE_RL 0
#endif
#ifndef PROBE_P0
#define PROBE_P0 0
#endif
#ifndef PROBE_DUP
#define PROBE_DUP -1
#endif
#ifndef MK_N_LAUNCHES
#define MK_N_LAUNCHES 1
#endif
namespace pg8 {
#define PG8_LAS __attribute__((address_space(3)))
typedef unsigned short bf16_t;
typedef short bf16x8 __attribute__((ext_vector_type(8)));
typedef float f32x4 __attribute__((ext_vector_type(4)));
typedef unsigned u32x4 __attribute__((ext_vector_type(4)));
constexpr int BM = 256, BK = 64, HALF = 128, HTB = HALF * BK * 2  , STAGE_BYTES = 8 * HTB, NXCD = 8, WGM = 8;

__host__ __device__ __forceinline__ int lds_byte(int r, int c) { const int st = (r >> 4) * 2 + (c >> 5), rr = r & 15, cc = c & 31, ob = rr * 64 + cc * 2; return st * 1024 + (ob ^ (((ob >> 9) & 1) << 5)); }
__host__ __device__ __forceinline__ void stage_rc(int b, int& R, int& C) { const int st = b / 1024, sb = b % 1024, swz = sb ^ (((sb >> 9) & 1) << 5); R = (st >> 1) * 16 + swz / 64; C = (st & 1) * 32 + (swz % 64) / 2; }
__host__ __device__ __forceinline__ int perm32(int rho) { const int n = rho >> 4, i = rho & 15; return 8 * (i >> 2) + 4 * n + (i & 3); }

struct Unit { int pm, pn; };
struct Gemm { const bf16_t* A; const bf16_t* Bt; int M, N, K; };

struct StaticOrder {
    int nM, nN, nwg, G, c;
    __host__ __device__ void init(int M, int N, int G_, int c_) { nM = M / BM; nN = N / BM; nwg = nM * nN; G = G_; c = c_; }
    __host__ __device__ bool next(int i, Unit& u) const {
        const long L = (long)i * G + c; if (L >= nwg) return false;
        int wgid = (int)L; { const int q = nwg / NXCD, r = nwg % NXCD, xcd = wgid % NXCD, off = wgid / NXCD; wgid = (xcd < r ? xcd * (q + 1) : r * (q + 1) + (xcd - r) * q) + off; }
        const int nig = WGM * nN, gid = wgid / nig, fm = gid * WGM, gsz = (nM - fm) < WGM ? (nM - fm) : WGM;
        u.pm = fm + ((wgid % nig) % gsz); u.pn = (wgid % nig) / gsz; return true;
    }
    __device__ __forceinline__ void a_ready(const Unit&) const {}
    __device__ __forceinline__ void done(const Unit&) const {}
};
__device__ __forceinline__ unsigned cvt_pk_bf16(float lo, float hi) { unsigned r; asm volatile("v_cvt_pk_bf16_f32 %0, %1, %2" : "=v"(r) : "v"(lo), "v"(hi)); return r; }
template <class Epi, class Sched, class Rider, bool STAMP = false>
__device__ __forceinline__ void gemm_phase(PG8_LAS unsigned char* lds, const Gemm g, const Sched& S, const Epi& E, Rider& R, unsigned long long* stamps) {
    const int tid = threadIdx.x, wid = __builtin_amdgcn_readfirstlane(tid >> 6), lane = tid & 63, wr = wid >> 2, wc = wid & 3, fr = lane & 15, fq = lane >> 4;
    const int K = g.K, nt = K / BK;
    int ts_lo = 0, ts_hi = 0, nts = 0; const unsigned long long rt_entry = STAMP ? (unsigned long long)wall_clock64() : 0ull;
#define PG8_STAMP() do { if (STAMP && wid == 0 && nts < 64) { const unsigned long long _c = (unsigned long long)clock64(); \
        ts_lo = (lane == nts) ? (int)(unsigned)_c : ts_lo; ts_hi = (lane == nts) ? (int)(unsigned)(_c >> 32) : ts_hi; ++nts; } } while (0)
    PG8_STAMP();
    unsigned voffA[2], voffB[2];
#pragma unroll
    for (int i = 0; i < 2; ++i) { int R, C; stage_rc(tid * 16 + i * 8192, R, C); const int Rb = Epi::PERM ? ((R & ~31) + perm32(R & 31)) : R;
        voffA[i] = (unsigned)(R * K + C) * 2u; voffB[i] = (unsigned)(Rb * K + C) * 2u; }
    const size_t kstep = (size_t)(BK * 2);
    const size_t hstep = (size_t)HALF * K * 2;
    const size_t tstep = 2 * hstep;
    const unsigned ldsw = (unsigned)wid * 1024u;
    const int aoff = lds_byte(wr * 64 + fr, fq * 8), boff = lds_byte(wc * 32 + fr, fq * 8);
#define PG8_SA(b, h) (((b) * 2 + (h)) * HTB)
#define PG8_SB(b, h) ((4 + (b) * 2 + (h)) * HTB)
#define PG8_STAGE(bufoff, gbase, voff) do { _Pragma("unroll") for (int _i = 0; _i < 2; ++_i) \
        __builtin_amdgcn_global_load_lds((const unsigned*)((const char*)(gbase) + (voff)[_i]), (PG8_LAS unsigned*)(lds + (bufoff) + ldsw + _i * 8192), 16, 0, 0); } while (0)
#define PG8_LDA(dst, b, h) do { _Pragma("unroll") for (int m = 0; m < 4; ++m) _Pragma("unroll") for (int k = 0; k < 2; ++k) dst[m][k] = *(const PG8_LAS bf16x8*)(lds + PG8_SA(b, h) + aoff + m * 2048 + k * 1024); } while (0)
#define PG8_LDB(dst, b, h) do { _Pragma("unroll") for (int n = 0; n < 2; ++n) _Pragma("unroll") for (int k = 0; k < 2; ++k) dst[n][k] = *(const PG8_LAS bf16x8*)(lds + PG8_SB(b, h) + boff + n * 2048 + k * 1024); } while (0)
#define PG8_MMA(ai, bj, At, Bt) do { __builtin_amdgcn_s_setprio(1); _Pragma("unroll") for (int m = 0; m < 4; ++m) _Pragma("unroll") for (int n = 0; n < 2; ++n) _Pragma("unroll") for (int k = 0; k < 2; ++k) \
        acc[ai][bj][m][n] = __builtin_amdgcn_mfma_f32_16x16x32_bf16(Bt[n][k], At[m][k], acc[ai][bj][m][n], 0, 0, 0); __builtin_amdgcn_s_setprio(0); } while (0)
#define PG8_WAIT_V(n) asm volatile("s_waitcnt vmcnt(" #n ")" ::: "memory")
#define PG8_WAIT_L(n) asm volatile("s_waitcnt lgkmcnt(" #n ")" ::: "memory")
#define PG8_BAR __builtin_amdgcn_s_barrier()
#define PG8_SCHED __builtin_amdgcn_sched_barrier(0)
    Unit cur, nxt; int ui = 0;
    if (!S.next(0, cur)) return;
    R.before_first();
    f32x4 acc[2][2][4][2];
#pragma unroll
    for (int a = 0; a < 2; ++a)
#pragma unroll
        for (int b = 0; b < 2; ++b)
#pragma unroll
            for (int m = 0; m < 4; ++m)
#pragma unroll
                for (int n = 0; n < 2; ++n) acc[a][b][m][n] = (f32x4){0.f, 0.f, 0.f, 0.f};
    bf16x8 At[4][2], B0[2][2], B1[2][2];
    const char* cA = (const char*)g.A + (size_t)cur.pm * tstep; const char* cB = (const char*)g.Bt + (size_t)cur.pn * tstep;
    S.a_ready(cur);
    PG8_STAGE(PG8_SB(0, 0), cB, voffB); PG8_STAGE(PG8_SA(0, 0), cA, voffA); PG8_STAGE(PG8_SB(0, 1), cB + hstep, voffB); PG8_STAGE(PG8_SA(0, 1), cA + hstep, voffA);
    if (wr == 1) PG8_BAR;
    PG8_WAIT_V(4); PG8_BAR;
    PG8_STAGE(PG8_SB(1, 0), cB + kstep, voffB); PG8_STAGE(PG8_SA(1, 0), cA + kstep, voffA); PG8_STAGE(PG8_SB(1, 1), cB + hstep + kstep, voffB);
    PG8_WAIT_V(6); PG8_BAR;
    PG8_STAMP();
    for (;;) {
        const bool has_next = S.next(ui + 1, nxt);
        const char* nA = has_next ? (const char*)g.A + (size_t)nxt.pm * tstep : cA; const char* nB = has_next ? (const char*)g.Bt + (size_t)nxt.pn * tstep : cB;
        for (int t = 0; t < nt; t += 2) {
            const bool last = (t == nt - 2);
            const char* a1 = cA + (size_t)(t + 1) * kstep;
            const char* a2 = last ? nA : cA + (size_t)(t + 2) * kstep; const char* b2 = last ? nB : cB + (size_t)(t + 2) * kstep;
            const char* a3 = a2 + kstep; const char* b3 = b2 + kstep;
            if (last && has_next) S.a_ready(nxt);
            PG8_LDB(B0, 0, 0); PG8_SCHED; PG8_LDA(At, 0, 0); PG8_STAGE(PG8_SA(1, 1), a1 + hstep, voffA);
            PG8_WAIT_L(8); PG8_BAR; PG8_WAIT_L(0); PG8_MMA(0, 0, At, B0); PG8_BAR; PG8_SCHED;
            PG8_LDB(B1, 0, 1); PG8_STAGE(PG8_SB(0, 0), b2, voffB);
            PG8_BAR; PG8_WAIT_L(0); PG8_MMA(0, 1, At, B1); PG8_BAR;
            PG8_LDA(At, 0, 1); PG8_STAGE(PG8_SA(0, 0), a2, voffA);
            PG8_BAR; PG8_WAIT_L(0); PG8_MMA(1, 0, At, B0); PG8_BAR; PG8_SCHED;
            PG8_STAGE(PG8_SB(0, 1), b2 + hstep, voffB);
            PG8_WAIT_V(6); R.store(); PG8_BAR; PG8_MMA(1, 1, At, B1); PG8_BAR;
            PG8_LDB(B0, 1, 0); PG8_SCHED; PG8_LDA(At, 1, 0); PG8_STAGE(PG8_SA(0, 1), a2 + hstep, voffA); R.load();
            PG8_WAIT_L(8); PG8_BAR; PG8_WAIT_L(0); PG8_MMA(0, 0, At, B0); PG8_BAR; PG8_SCHED;
            PG8_LDB(B1, 1, 1); PG8_STAGE(PG8_SB(1, 0), b3, voffB);
            PG8_BAR; PG8_WAIT_L(0); PG8_MMA(0, 1, At, B1); PG8_BAR;
            PG8_LDA(At, 1, 1); PG8_STAGE(PG8_SA(1, 0), a3, voffA);
            PG8_BAR; PG8_WAIT_L(0); PG8_MMA(1, 0, At, B0); PG8_BAR; PG8_SCHED;
            PG8_STAGE(PG8_SB(1, 1), b3 + hstep, voffB);
            R.wait8(); PG8_BAR; PG8_MMA(1, 1, At, B1); PG8_BAR;
        }
        PG8_STAMP();
        if constexpr (!Epi::AFTER_DRAIN) { E(acc, cur, wr, wc, fr, fq); S.done(cur); }
        R.unit_done(ui);
        PG8_STAMP();
        if (!has_next) break;
#pragma unroll
        for (int a = 0; a < 2; ++a)
#pragma unroll
            for (int b = 0; b < 2; ++b)
#pragma unroll
                for (int m = 0; m < 4; ++m)
#pragma unroll
                    for (int n = 0; n < 2; ++n) acc[a][b][m][n] = (f32x4){0.f, 0.f, 0.f, 0.f};
        cur = nxt; cA = nA; cB = nB; ++ui;
    }
    PG8_WAIT_V(0); R.store();
    if (wr == 0) PG8_BAR;
    PG8_BAR;
    if constexpr (Epi::AFTER_DRAIN) { E.fused(acc, cur, wr, wc, fr, fq, lds, wid, lane); S.done(cur); }
    PG8_STAMP();
    if (STAMP && wid == 0) { stamps[lane] = lane < nts ? (((unsigned long long)(unsigned)ts_hi << 32) | (unsigned)ts_lo) : 0ull;
        if (lane == 62) stamps[62] = rt_entry; if (lane == 63) stamps[63] = (unsigned long long)wall_clock64(); }
#undef PG8_STAMP
#undef PG8_SA
#undef PG8_SB
#undef PG8_STAGE
#undef PG8_LDA
#undef PG8_LDB
#undef PG8_MMA
#undef PG8_WAIT_V
#undef PG8_WAIT_L
#undef PG8_BAR
#undef PG8_SCHED
}
}

#define LAS __attribute__((address_space(3)))
typedef unsigned short bf16_t;
typedef short bf16x8 __attribute__((ext_vector_type(8)));
typedef short s16x4 __attribute__((ext_vector_type(4)));
typedef float f32x4 __attribute__((ext_vector_type(4)));
typedef float f32x16 __attribute__((ext_vector_type(16)));
typedef unsigned u32x4 __attribute__((ext_vector_type(4)));
typedef unsigned u32x2 __attribute__((ext_vector_type(2)));
using pg8::cvt_pk_bf16;

#define XB_TMO      128
#define XB_XCNT(j)  (256  + 64 * (j))
#define XB_XSUB(j)  (1280 + 64 * (j))
#define XB_XGEN(j)  (2304 + 64 * (j))
#define XB_TOP      3328
#define XB_TOPGEN   3392
#define XCD_BAR_WORDS 3456
#define XB_SPIN_CAP (1u << 18)

__device__ __forceinline__ unsigned xb_ld(unsigned* p)              { return __hip_atomic_load(p, __ATOMIC_RELAXED, __HIP_MEMORY_SCOPE_AGENT); }
__device__ __forceinline__ unsigned xb_add(unsigned* p, unsigned v) { return __hip_atomic_fetch_add(p, v, __ATOMIC_RELAXED, __HIP_MEMORY_SCOPE_AGENT); }
__device__ __forceinline__ unsigned xb_xcc_id() { return (unsigned)__builtin_amdgcn_s_getreg((3 << 11) | 20) & 0xFu; }
#define XB_SPIN(cond, bar) do { unsigned _sp = 0; while (cond) { __builtin_amdgcn_s_sleep(1); \
    if ((++_sp & 255u) == 0u) { if (xb_ld(&(bar)[XB_TMO])) break; if (_sp > XB_SPIN_CAP) { atomicAdd(&(bar)[XB_TMO], 1u); break; } } } } while (0)

struct XcdBarrier {
    unsigned* bar; unsigned x;
    volatile LAS unsigned* st;
};

__device__ __forceinline__ XcdBarrier xcd_barrier_post(unsigned* bar, volatile LAS unsigned* st) {
    XcdBarrier b; b.bar = bar; b.x = xb_xcc_id(); b.st = st;
    if (threadIdx.x == 0) (void)xb_add(&bar[XB_XCNT(b.x)], 1u);
    return b;
}
__device__ __forceinline__ void xcd_barrier_complete(unsigned* bar, unsigned x, unsigned& nloc, unsigned& nx) {
    const unsigned G = gridDim.x * gridDim.y * gridDim.z;
    unsigned sum, cnt, mine, sp = 0u;
    for (;;) {
        sum = 0u; cnt = 0u; mine = 0u;
#pragma unroll
        for (unsigned j = 0; j < 16; ++j) { const unsigned c = xb_ld(&bar[XB_XCNT(j)]); sum += c; cnt += (c > 0u) ? 1u : 0u; mine = (j == x) ? c : mine; }
        if (sum == G) break;
        __builtin_amdgcn_s_sleep(1);
        if ((++sp & 255u) == 0u) { if (xb_ld(&bar[XB_TMO])) break; if (sp > XB_SPIN_CAP) { atomicAdd(&bar[XB_TMO], 1u); break; } }
    }
    nloc = mine > 0u ? mine : 1u; nx = cnt > 0u ? cnt : 1u;
}

__device__ __forceinline__ void xcd_barrier(const XcdBarrier& b) {
    asm volatile("s_waitcnt vmcnt(0)" ::: "memory");
    __syncthreads();
    if (threadIdx.x == 0) {
        unsigned* bar = b.bar;
        __builtin_amdgcn_s_waitcnt(0);
        unsigned nloc = b.st[0], nx = b.st[1];
        if (nloc == 0u) { xcd_barrier_complete(bar, b.x, nloc, nx); b.st[0] = nloc; b.st[1] = nx; }
        const unsigned old = xb_add(&bar[XB_XSUB(b.x)], 1u);
        const unsigned gen = old / nloc;
        if (old + 1u == (gen + 1u) * nloc) {
            __builtin_amdgcn_fence(__ATOMIC_RELEASE, "agent");
            asm volatile("s_waitcnt vmcnt(0)" ::: "memory");
            const unsigned og = xb_add(&bar[XB_TOP], 1u);
            const unsigned tg = og / nx;
            if (og + 1u == (tg + 1u) * nx) xb_add(&bar[XB_TOPGEN], 1u);
            else XB_SPIN(xb_ld(&bar[XB_TOPGEN]) == tg, bar);
            __builtin_amdgcn_fence(__ATOMIC_ACQUIRE, "agent");
            xb_add(&bar[XB_XGEN(b.x)], 1u);
            asm volatile("s_waitcnt vmcnt(0)" ::: "memory");
        } else {
            XB_SPIN(xb_ld(&bar[XB_XGEN(b.x)]) == gen, bar);
            __builtin_amdgcn_fence(__ATOMIC_ACQUIRE, "agent");
            asm volatile("s_waitcnt vmcnt(0)" ::: "memory");
        }
    }
    __syncthreads();
}

constexpr int DM = 2048, NPR = 8192, NSM = 128, MROWS = 8320, MPAD = 8448;
constexpr int DIN = 7680, SEQ = 2048, NBP = 4, NBS = 32, DT = 4, NH = 12;
constexpr int LDZ = 6144;
constexpr float EPS = 1e-6f;
constexpr float LOG2E = 1.4426950408889634f;
constexpr float QSCALE = 0.08838834764831845f * 1.4426950408889634f;
constexpr float NEGBIG = -1e30f;
constexpr size_t O_YP = 0, O_YS = 16777216, O_CP = 17039360, O_KVP = 17100800, O_CS = 42266624, O_KVS = 42758144;
constexpr size_t MiB = 1u << 20;
constexpr size_t WS_CTL = 0, CTL_BYTES = 65536;
constexpr size_t WS_WIN = 1 * MiB, WS_WOUT = 32 * MiB, WS_WPW = 40 * MiB, WS_TAB = 41 * MiB, WS_H = 42 * MiB, WS_Z = 76 * MiB, WS_GC = 176 * MiB;
constexpr size_t WS_UPP = 186 * MiB, WS_UPS = 195 * MiB, WS_MIX = 198 * MiB, WS_Y = 232 * MiB, WS_END = 300 * MiB;
constexpr int TAB_NEG = 384, TAB_N = 2688;
constexpr int LDS_TAB = 131072, LDS_AL = LDS_TAB + TAB_N * 4, LDS_MISC = LDS_AL + 2048, LDS_BYTES = 147456;
static_assert(LDS_MISC + 256 <= LDS_BYTES, "LDS map");

struct Params { const float* in[15]; float* out; unsigned char* ws; int ph_lo, ph_hi; };

__device__ __forceinline__ size_t opaque0() { size_t z = 0; asm volatile("" : "+s"(z)); return z; }
template <class V> __device__ __forceinline__ void st16_hidden(void* ptr, V v) { static_assert(sizeof(V) == 16, ""); asm volatile("global_store_dwordx4 %0, %1, off\n\ts_nop 1" :: "v"(ptr), "v"(v) : "memory"); }
template <class V> __device__ __forceinline__ void st16_hidden_nt(void* ptr, V v) { static_assert(sizeof(V) == 16, ""); asm volatile("global_store_dwordx4 %0, %1, off nt\n\ts_nop 1" :: "v"(ptr), "v"(v) : "memory"); }
__device__ __forceinline__ void st8_hidden(void* ptr, unsigned long long v) { asm volatile("global_store_dwordx2 %0, %1, off\n\ts_nop 1" :: "v"(ptr), "v"(v) : "memory"); }
__device__ __forceinline__ float bf2f(bf16_t v) { return __uint_as_float(((unsigned)v) << 16); }
__device__ __forceinline__ bf16_t f2bf(float f) { unsigned u = __float_as_uint(f); return (bf16_t)((u + 0x7fffu + ((u >> 16) & 1u)) >> 16); }
__device__ __forceinline__ float wave_sum(float v) {
#pragma unroll
    for (int o = 1; o < 64; o <<= 1) v += __shfl_xor(v, o);
    return v;
}
__device__ __forceinline__ float fast_sigmoid(float x) { return __builtin_amdgcn_rcpf(1.0f + __builtin_amdgcn_exp2f(-x * LOG2E)); }
__device__ __forceinline__ float silu_f(float x) { return x * fast_sigmoid(x); }

__device__ __forceinline__ void p0_transpose_item(const float* __restrict__ W, int K, int N, bf16_t* __restrict__ WT, int k0, int nsrc0, int ndst0, LAS float* scr, int lane) {
    f32x4 tv[16];
    const int lr = lane >> 4, lc = 4 * (lane & 15);
#pragma unroll
    for (int i = 0; i < 16; ++i) tv[i] = __builtin_nontemporal_load((const f32x4*)(W + (size_t)(k0 + 4 * i + lr) * N + nsrc0 + lc));
#pragma unroll
    for (int i = 0; i < 16; ++i) { LAS float* d = scr + (4 * i + lr) * 65 + lc; d[0] = tv[i].x; d[1] = tv[i].y; d[2] = tv[i].z; d[3] = tv[i].w; }
    asm volatile("s_waitcnt lgkmcnt(0)" ::: "memory");
    const int c = lane & 7;
#pragma unroll
    for (int j = 0; j < 8; ++j) { const int n = (lane >> 3) + 8 * j; const LAS float* sp = scr + (8 * c) * 65 + n;
        u32x4 o; o.x = cvt_pk_bf16(sp[0 * 65], sp[1 * 65]); o.y = cvt_pk_bf16(sp[2 * 65], sp[3 * 65]); o.z = cvt_pk_bf16(sp[4 * 65], sp[5 * 65]); o.w = cvt_pk_bf16(sp[6 * 65], sp[7 * 65]);
        *(u32x4*)(WT + (size_t)(ndst0 + n) * K + k0 + 8 * c) = o; }
    asm volatile("s_waitcnt lgkmcnt(0)" ::: "memory");
}
__device__ __forceinline__ int win_src_col(int nv) {
    if (nv < 6144 || nv >= 7168) return nv;
    const int g = (nv - 6144) >> 8, r = (nv - 6144) & 255;
    return r < 128 ? 6144 + 128 * g + r : 6656 + 128 * g + (r - 128);
}
__device__ __forceinline__ int rel_bucket(int dist) {
    if (dist < 16) return dist;
    const double d = (double)dist;
    int lb = 16 + (int)(log(d / 16.0) / log(128.0) * 16.0);
    return lb < 31 ? lb : 31;
}
__device__ __forceinline__ void p0_prologue(const Params& p, LAS unsigned char* lds) {
    const int tid = threadIdx.x, lane = tid & 63, wave = tid >> 6;
    const int gw = blockIdx.x * 8 + wave, NGW = gridDim.x * 8;
    const size_t gt = (size_t)blockIdx.x * 512 + tid, NGT = (size_t)gridDim.x * 512;
    unsigned char* ws = p.ws;
    _Pragma("unroll 1") for (int rep_ = 0; rep_ < (PROBE_P0 == 1 ? 3 : 1); ++rep_)
    {
        LAS float* scr = (LAS float*)(lds + wave * 17408);
        constexpr int I_IN = 32 * 120, I_OUT = 32 * 32, I_PW = 8 * 8;
        bf16_t* WinT = (bf16_t*)(ws + WS_WIN); bf16_t* WoutT = (bf16_t*)(ws + WS_WOUT); bf16_t* WpwT = (bf16_t*)(ws + WS_WPW);
        for (int it = gw; it < I_IN + I_OUT + I_PW; it += NGW) {
            int r = it;
            if (r < I_IN) { const int kb = r / 120, nb = r % 120; p0_transpose_item(p.in[6], 2048, DIN, WinT, 64 * kb, win_src_col(64 * nb), 64 * nb, scr, lane); continue; } r -= I_IN;
            if (r < I_OUT) { const int kb = r / 32, nb = r % 32; p0_transpose_item(p.in[13], 2048, 2048, WoutT, 64 * kb, 64 * nb, 64 * nb, scr, lane); continue; } r -= I_OUT;
            { const int kb = r / 8, nb = r % 8; p0_transpose_item(p.in[11], 512, 512, WpwT, 64 * kb, 64 * nb, 64 * nb, scr, lane); }
        }
    }
    _Pragma("unroll 1") for (int rep_ = 0; rep_ < (PROBE_P0 == 2 ? 3 : 1); ++rep_)
    {
        bf16_t* H = (bf16_t*)(ws + WS_H);
        const f32x4* gp = (const f32x4*)p.in[5] + lane;
        f32x4 gq[8];
#pragma unroll
        for (int j = 0; j < 8; ++j) gq[j] = gp[64 * j];
        for (int m0 = gw; m0 < MPAD; m0 += 2 * NGW) {
            const int m1 = m0 + NGW; const bool r0 = m0 < MROWS, r1 = m1 < MROWS;
            const float* x0 = m0 < NPR ? p.in[0] + (size_t)m0 * DM : p.in[1] + (size_t)(m0 - NPR) * DM;
            const float* x1 = m1 < NPR ? p.in[0] + (size_t)m1 * DM : p.in[1] + (size_t)(m1 - NPR) * DM;
            f32x4 v0[8], v1[8];
#pragma unroll
            for (int j = 0; j < 8; ++j) { v0[j] = r0 ? __builtin_nontemporal_load((const f32x4*)x0 + lane + 64 * j) : (f32x4){0.f, 0.f, 0.f, 0.f};
                                          v1[j] = r1 ? __builtin_nontemporal_load((const f32x4*)x1 + lane + 64 * j) : (f32x4){0.f, 0.f, 0.f, 0.f}; }
            __builtin_amdgcn_sched_barrier(0);
            float s0 = 0.f, s1 = 0.f;
#pragma unroll
            for (int j = 0; j < 8; ++j) { s0 += (v0[j].x * v0[j].x + v0[j].y * v0[j].y) + (v0[j].z * v0[j].z + v0[j].w * v0[j].w); s1 += (v1[j].x * v1[j].x + v1[j].y * v1[j].y) + (v1[j].z * v1[j].z + v1[j].w * v1[j].w); }
            const float rs0 = 1.0f / sqrtf(wave_sum(s0) * (1.f / DM) + EPS), rs1 = 1.0f / sqrtf(wave_sum(s1) * (1.f / DM) + EPS);
            unsigned long long* o0 = (unsigned long long*)(H + (size_t)m0 * DM) + lane; unsigned long long* o1 = (unsigned long long*)(H + (size_t)m1 * DM) + lane;
#pragma unroll
            for (int j = 0; j < 8; ++j) { const f32x4 g = gq[j];
                o0[64 * j] = (unsigned long long)cvt_pk_bf16(v0[j].x * rs0 * g.x, v0[j].y * rs0 * g.y) | ((unsigned long long)cvt_pk_bf16(v0[j].z * rs0 * g.z, v0[j].w * rs0 * g.w) << 32);
                if (m1 < MPAD) o1[64 * j] = (unsigned long long)cvt_pk_bf16(v1[j].x * rs1 * g.x, v1[j].y * rs1 * g.y) | ((unsigned long long)cvt_pk_bf16(v1[j].z * rs1 * g.z, v1[j].w * rs1 * g.w) << 32); }
        }
    }
    {
        bf16_t* UPP = (bf16_t*)(ws + WS_UPP); bf16_t* UPS = (bf16_t*)(ws + WS_UPS);
        for (size_t i = gt; i < (size_t)NBP * 30 * 512; i += NGT) { const size_t b = i / (30 * 512), r = i % (30 * 512); UPP[b * 2078 * 512 + r] = 0; }
        const float* cc = p.in[2];
        for (size_t i = gt; i < (size_t)NBS * 30 * 512; i += NGT) { const size_t b = i / (30 * 512), r = i % (30 * 512); const float v = cc[i];
            UPS[b * 34 * 512 + r] = f2bf(v);
            if (r >= 4 * 512) p.out[O_CS + b * 30 * 512 + (r - 4 * 512)] = v; }
    }
    _Pragma("unroll 1") for (int rep_ = 0; rep_ < (PROBE_P0 == 4 ? 3 : 1); ++rep_)
    {
        float* tabg = (float*)(ws + WS_TAB); const float* rb = p.in[4];
        for (size_t i = gt; i < (size_t)NH * TAB_N; i += NGT) {
            const int h = (int)(i / TAB_N), dist = (int)(i % TAB_N) - TAB_NEG; float v = NEGBIG;
            if (dist >= 0 && dist <= 2048) {
                const int mult = (dist <= 128 ? 1 : 0) + (((dist & 3) == 0 && dist <= 512) ? 1 : 0) + ((dist & 15) == 0 ? 1 : 0);
                if (mult > 0) v = rb[rel_bucket(dist) * NH + h] * LOG2E + (mult == 1 ? 0.f : (mult == 2 ? 1.f : 1.5849625007211562f));
            }
            tabg[i] = v;
        }
    }
}

constexpr int POOL_FIRST = 0;
constexpr int CP_STATIC = 6, CP_POOL = (12 - CP_STATIC) * 256;
struct CopyBurst {
    const float* cache; float* out_kvs; int slot; bool done;
    __device__ __forceinline__ void init(const float* c, float* o, int slot_) { cache = c; out_kvs = o; slot = slot_; done = false; }
    __device__ __forceinline__ void burst(int owner, int gi0, int gi1) {
        const size_t b = (size_t)(owner >> 3), part = (size_t)(owner & 7);
        const f32x4* src = (const f32x4*)cache + b * ((size_t)2048 * 768) + threadIdx.x + 4 * 768;
        f32x4* dst = (f32x4*)out_kvs + b * ((size_t)2048 * 768) + threadIdx.x;
        f32x4 va[9], vb[9];
#pragma unroll
        for (int u = 0; u < 9; ++u) { va[u] = (f32x4){0.f, 0.f, 0.f, 0.f}; vb[u] = (f32x4){0.f, 0.f, 0.f, 0.f}; }
#define CB_LOAD(V, P) do { _Pragma("unroll") for (int u = 0; u < 9; ++u) asm volatile("global_load_dwordx4 %0, %1, off sc0 sc1 nt" : "+v"(V[u]) : "v"((P) + u * 512) : "memory"); } while (0)
#define CB_STORE(V, P) do { _Pragma("unroll") for (int u = 0; u < 9; ++u) asm volatile("global_store_dwordx4 %0, %1, off nt\n\ts_nop 1" :: "v"((P) + u * 512), "v"(V[u]) : "memory"); } while (0)
#define CB_WAIT9(V) asm volatile("s_waitcnt vmcnt(9)" ::: "memory")
#define CB_WAIT0(V) asm volatile("s_waitcnt vmcnt(0)" ::: "memory")
        asm volatile("s_waitcnt vmcnt(0)" ::: "memory");
        const size_t g0 = (size_t)(12 * part) * 16 * 768;
#pragma unroll 1
        for (int gi = gi0; gi < gi1; ++gi) {
            const size_t oa = g0 + (size_t)gi * 16 * 768, ob = oa + 4608;
            CB_LOAD(va, src + oa);
            CB_LOAD(vb, src + ob);
            CB_WAIT9(va);
            CB_STORE(va, dst + oa);
            CB_WAIT0(vb);
            CB_STORE(vb, dst + ob);
        }
        asm volatile("s_waitcnt vmcnt(0)" ::: "memory");
#undef CB_LOAD
#undef CB_STORE
#undef CB_WAIT9
#undef CB_WAIT0
    }
    __device__ __forceinline__ void before_first() { if (slot == 0) { burst((int)blockIdx.x, 0, CP_STATIC); done = true; } }
    __device__ __forceinline__ void unit_done(int ui) { if (!done && ui + 1 == slot) { burst((int)blockIdx.x, 0, CP_STATIC); done = true; } }
    __device__ __forceinline__ void finish() { if (!done) { burst((int)blockIdx.x, 0, CP_STATIC); done = true; } }
    __device__ __forceinline__ void load() {} __device__ __forceinline__ void store() {}
    __device__ __forceinline__ void wait8() { asm volatile("s_waitcnt vmcnt(6)" ::: "memory"); }
};
struct NoRider { __device__ __forceinline__ void load() {} __device__ __forceinline__ void store() {} __device__ __forceinline__ void wait8() { asm volatile("s_waitcnt vmcnt(6)" ::: "memory"); }
    __device__ __forceinline__ void before_first() {} __device__ __forceinline__ void unit_done(int) {} };

struct EpiInProj {
    static constexpr bool PERM = true, AFTER_DRAIN = false;
    bf16_t* Z; bf16_t* GC; bf16_t* UPP; bf16_t* UPS; float* out;
    __device__ __forceinline__ void operator()(const f32x4 (&acc)[2][2][4][2], const pg8::Unit& u, int wr, int wc, int fr, int fq) const {
        const int pn = u.pn;
        const int row0 = u.pm * 256 + wr * 64 + fr, cw = wc * 32 + 8 * fq;
        if (pn < 24) {
            const int kind = pn < 6 ? 0 : (pn < 18 ? 1 : 2);
#pragma unroll
            for (int ai = 0; ai < 2; ++ai)
#pragma unroll
                for (int m = 0; m < 4; ++m) {
                    const int r = row0 + ai * 128 + m * 16;
                    if (r >= MROWS) continue;
                    bf16_t* zrow = Z + (size_t)r * LDZ + pn * 256 + cw;
                    float* kvrow = nullptr;
                    if (kind == 1) { const size_t orow = r < NPR ? (size_t)r : (size_t)((r - NPR) >> 2) * 2048 + 2044 + ((r - NPR) & 3);
                        kvrow = out + (r < NPR ? O_KVP : O_KVS) + orow * 3072 + (pn * 256 - 1536) + cw; }
#pragma unroll
                    for (int bj = 0; bj < 2; ++bj) { f32x4 v0 = acc[ai][bj][m][0], v1 = acc[ai][bj][m][1];
                        if (kind == 1) { __builtin_nontemporal_store(v0, (f32x4*)(kvrow + bj * 128)); __builtin_nontemporal_store(v1, (f32x4*)(kvrow + bj * 128 + 4)); }
                        if (kind == 0) { v0 *= QSCALE; v1 *= QSCALE; }
                        if (kind == 2) {
#pragma unroll
                            for (int j = 0; j < 4; ++j) { v0[j] = silu_f(v0[j]); v1[j] = silu_f(v1[j]); } }
                        u32x4 w; w.x = cvt_pk_bf16(v0[0], v0[1]); w.y = cvt_pk_bf16(v0[2], v0[3]); w.z = cvt_pk_bf16(v1[0], v1[1]); w.w = cvt_pk_bf16(v1[2], v1[3]);
                        *(u32x4*)(zrow + bj * 128) = w; }
                }
        } else if (pn < 28) {
            const int cu = (pn - 24) * 128 + cw;
#pragma unroll
            for (int ai = 0; ai < 2; ++ai)
#pragma unroll
                for (int m = 0; m < 4; ++m) {
                    const int r = row0 + ai * 128 + m * 16;
                    if (r >= MROWS) continue;
                    f32x4 a0 = acc[ai][0][m][0], a1 = acc[ai][0][m][1]; const f32x4 b0 = acc[ai][1][m][0], b1 = acc[ai][1][m][1];
#pragma unroll
                    for (int j = 0; j < 4; ++j) { a0[j] *= fast_sigmoid(b0[j]); a1[j] *= fast_sigmoid(b1[j]); }
                    u32x4 w; w.x = cvt_pk_bf16(a0[0], a0[1]); w.y = cvt_pk_bf16(a0[2], a0[3]); w.z = cvt_pk_bf16(a1[0], a1[1]); w.w = cvt_pk_bf16(a1[2], a1[3]);
                    if (r < NPR) { const int b = r >> 11, t = r & 2047;
                        *(u32x4*)(UPP + ((size_t)b * 2078 + 30 + t) * 512 + cu) = w;
                        if (t >= 2018) { float* o = out + O_CP + ((size_t)b * 30 + (t - 2018)) * 512 + cu; *(f32x4*)o = a0; *(f32x4*)(o + 4) = a1; } }
                    else { const int b = (r - NPR) >> 2, j = (r - NPR) & 3;
                        *(u32x4*)(UPS + ((size_t)b * 34 + 30 + j) * 512 + cu) = w;
                        float* o = out + O_CS + ((size_t)b * 30 + 26 + j) * 512 + cu; *(f32x4*)o = a0; *(f32x4*)(o + 4) = a1; }
                }
        } else {
#pragma unroll
            for (int ai = 0; ai < 2; ++ai)
#pragma unroll
                for (int m = 0; m < 4; ++m) {
                    const int r = row0 + ai * 128 + m * 16;
                    if (r >= MROWS) continue;
                    bf16_t* grow = GC + (size_t)r * 512 + (pn - 28) * 256 + cw;
#pragma unroll
                    for (int bj = 0; bj < 2; ++bj) { f32x4 v0 = acc[ai][bj][m][0], v1 = acc[ai][bj][m][1];
#pragma unroll
                        for (int j = 0; j < 4; ++j) { v0[j] = silu_f(v0[j]); v1[j] = silu_f(v1[j]); }
                        u32x4 w; w.x = cvt_pk_bf16(v0[0], v0[1]); w.y = cvt_pk_bf16(v0[2], v0[3]); w.z = cvt_pk_bf16(v1[0], v1[1]); w.w = cvt_pk_bf16(v1[2], v1[3]);
                        *(u32x4*)(grow + bj * 128) = w; }
                }
        }
    }
};
struct EpiOutProj {
    static constexpr bool PERM = false, AFTER_DRAIN = false;
    float* C;
    __device__ __forceinline__ void operator()(const f32x4 (&acc)[2][2][4][2], const pg8::Unit& u, int wr, int wc, int fr, int fq) const {
        const int row0 = u.pm * 256 + wr * 64 + fr, col0 = u.pn * 256 + wc * 32 + 4 * fq;
#pragma unroll
        for (int ai = 0; ai < 2; ++ai)
#pragma unroll
            for (int m = 0; m < 4; ++m) { float* rowp = C + (size_t)(row0 + ai * 128 + m * 16) * DM + col0;
#pragma unroll
                for (int bj = 0; bj < 2; ++bj)
#pragma unroll
                    for (int n = 0; n < 2; ++n) *(f32x4*)(rowp + bj * 128 + n * 16) = acc[ai][bj][m][n]; }
    }
};

constexpr size_t WS_XCH = 41 * MiB + 512 * 1024;
constexpr int CW_PANEL = 8192, CW_SAMPLE = 8192 + 64 * 32;
struct EpiOutFused {
    static constexpr bool PERM = false, AFTER_DRAIN = true;
    const float* x; float* out; const float* g; unsigned* X; unsigned* ctl;
    __device__ __forceinline__ void fused(f32x4 (&acc)[2][2][4][2], const pg8::Unit& u, int wr, int wc, int fr, int fq, LAS unsigned char* lds, int wid, int lane) const {
        LAS float* P = (LAS float*)lds;
        LAS float* S = (LAS float*)(lds + 4096);
        const int tid = wid * 64 + lane;
#pragma unroll
        for (int ai = 0; ai < 2; ++ai)
#pragma unroll
            for (int m = 0; m < 4; ++m) { float s = 0.f;
#pragma unroll
                for (int bj = 0; bj < 2; ++bj)
#pragma unroll
                    for (int n = 0; n < 2; ++n) { const f32x4 v = acc[ai][bj][m][n]; s += (v.x * v.x + v.y * v.y) + (v.z * v.z + v.w * v.w); }
                s += __shfl_xor(s, 16); s += __shfl_xor(s, 32);
                if (fq == 0) P[(ai * 128 + wr * 64 + m * 16 + fr) * 4 + wc] = s; }
        asm volatile("s_waitcnt lgkmcnt(0)" ::: "memory"); __syncthreads();
        unsigned* cnt = ctl + CW_PANEL + 64 * u.pm;
        if (tid < 256) { const f32x4 pv = *(const LAS f32x4*)(P + tid * 4);
            __hip_atomic_store(X + ((size_t)u.pm * 8 + u.pn) * 256 + tid, __float_as_uint((pv.x + pv.y) + (pv.z + pv.w)), __ATOMIC_RELAXED, __HIP_MEMORY_SCOPE_AGENT); }
        asm volatile("s_waitcnt vmcnt(0)" ::: "memory");
        if (wid < 4 && lane == 0) __hip_atomic_fetch_add(cnt, 1u, __ATOMIC_RELAXED, __HIP_MEMORY_SCOPE_AGENT);
        if (wid == 0) { unsigned sp = 0;
            while ((unsigned)__builtin_amdgcn_readfirstlane(__hip_atomic_load(cnt, __ATOMIC_RELAXED, __HIP_MEMORY_SCOPE_AGENT)) < 32u) { __builtin_amdgcn_s_sleep(2); if (++sp > (1u << 20)) break; }
            __builtin_amdgcn_fence(__ATOMIC_ACQUIRE, "agent"); }
        asm volatile("s_waitcnt vmcnt(0) lgkmcnt(0)" ::: "memory"); __syncthreads();
        if (tid < 256) { float t = 0.f;
#pragma unroll
            for (int k = 0; k < 8; ++k) t += __uint_as_float(__hip_atomic_load(X + ((size_t)u.pm * 8 + k) * 256 + tid, __ATOMIC_RELAXED, __HIP_MEMORY_SCOPE_AGENT));
            S[tid] = 1.0f / sqrtf(t * (1.f / DM) + EPS); }
        asm volatile("s_waitcnt lgkmcnt(0)" ::: "memory"); __syncthreads();
        const int col0 = u.pn * 256 + wc * 32 + 4 * fq;
        f32x4 gv[2][2];
#pragma unroll
        for (int bj = 0; bj < 2; ++bj)
#pragma unroll
            for (int n = 0; n < 2; ++n) gv[bj][n] = *(const f32x4*)(g + col0 + bj * 128 + n * 16);
#pragma unroll
        for (int ai = 0; ai < 2; ++ai) {
            f32x4 xv[4][2][2]; float rs[4];
#pragma unroll
            for (int m = 0; m < 4; ++m) { const int r = ai * 128 + wr * 64 + m * 16 + fr; rs[m] = S[r]; const size_t off = (size_t)(u.pm * 256 + r) * DM + col0;
#pragma unroll
                for (int bj = 0; bj < 2; ++bj)
#pragma unroll
                    for (int n = 0; n < 2; ++n) xv[m][bj][n] = __builtin_nontemporal_load((const f32x4*)(x + off + bj * 128 + n * 16)); }
            __builtin_amdgcn_sched_barrier(0);
#pragma unroll
            for (int m = 0; m < 4; ++m) { const int r = ai * 128 + wr * 64 + m * 16 + fr; const size_t off = (size_t)(u.pm * 256 + r) * DM + col0;
#pragma unroll
                for (int bj = 0; bj < 2; ++bj)
#pragma unroll
                    for (int n = 0; n < 2; ++n) *(f32x4*)(out + off + bj * 128 + n * 16) = xv[m][bj][n] + acc[ai][bj][m][n] * rs[m] * gv[bj][n]; }
            __builtin_amdgcn_sched_barrier(0);
        }
    }
};

#define KSWZ(row, colB) ((row) * 256 + ((colB) ^ (((row) & 7) << 4)))
__device__ __forceinline__ int crow(int r, int hi) { return (r & 3) + 8 * (r >> 2) + 4 * hi; }
__device__ __forceinline__ int v_st(int k, int c) { const int kk = (k & ~0xC) | ((k & 4) << 1) | ((k & 8) >> 1); return ((kk >> 3) * 4 + (c >> 5)) * 512 + ((kk & 7) * 32 + (c & 31)) * 2; }
__device__ __forceinline__ int v_rd_base(int lane) { return ((lane & 3) << 3) | (((lane >> 2) & 3) << 6) | (((lane >> 4) & 1) << 5) | (((lane >> 5) & 1) << 8); }
constexpr int v_rd_off(int d0, int ks, int half) { return d0 * 512 + ks * 4096 + half * 2048; }
template <int OFF> __device__ __forceinline__ s16x4 tr_read(int vb) {
    s16x4 r; asm volatile("ds_read_b64_tr_b16 %0, %1 offset:%2" : "=&v"(r) : "v"(vb), "i"(OFF) : "memory"); return r;
}
template <int D0> __device__ __forceinline__ void pv_one(f32x16& od, int vb, bf16x8 pa0, bf16x8 pa1) {
    const s16x4 l0 = tr_read<v_rd_off(D0, 0, 0)>(vb), h0 = tr_read<v_rd_off(D0, 0, 1)>(vb), l1 = tr_read<v_rd_off(D0, 1, 0)>(vb), h1 = tr_read<v_rd_off(D0, 1, 1)>(vb);
    asm volatile("s_waitcnt lgkmcnt(0)" ::: "memory"); __builtin_amdgcn_sched_barrier(0);
#define PKV(L, H) (bf16x8){L[0], L[1], L[2], L[3], H[0], H[1], H[2], H[3]}
    od = __builtin_amdgcn_mfma_f32_32x32x16_bf16(pa0, PKV(l0, h0), od, 0, 0, 0);
    od = __builtin_amdgcn_mfma_f32_32x32x16_bf16(pa1, PKV(l1, h1), od, 0, 0, 0);
#undef PKV
}
constexpr float ATT_THR = 8.0f;
__device__ __forceinline__ void attn_tile(const LAS unsigned char* Kt, int vb, const bf16x8 (&qr)[8], const LAS float* tabp, f32x16 (&o)[4], float& m_reg, float& l_reg,
                                          LAS float* al_l, int r32, int hi) {
    f32x16 p = {};
#pragma unroll
    for (int d0 = 0; d0 < 8; ++d0) { const int cb = (d0 * 16 + hi * 8) * 2;
        const bf16x8 kf = *(const LAS bf16x8*)(Kt + KSWZ(r32, cb));
        p = __builtin_amdgcn_mfma_f32_32x32x16_bf16(kf, qr[d0], p, 0, 0, 0); }
#pragma unroll
    for (int r = 0; r < 16; ++r) p[r] += tabp[-(4 * (r & 3) + 32 * (r >> 2))];
    float pmax = p[0];
#pragma unroll
    for (int r = 1; r < 16; ++r) pmax = fmaxf(pmax, p[r]);
    pmax = fmaxf(pmax, __shfl_xor(pmax, 32));
    float mn, alpha;
    if (__all(pmax - m_reg <= ATT_THR)) { mn = m_reg; alpha = 1.f; }
    else { mn = fmaxf(m_reg, pmax); alpha = __builtin_amdgcn_exp2f(m_reg - mn); m_reg = mn; }
    float ps = 0.f;
#pragma unroll
    for (int r = 0; r < 16; ++r) { p[r] = __builtin_amdgcn_exp2f(p[r] - mn); ps += p[r]; }
    ps += __shfl_xor(ps, 32);
    l_reg = l_reg * alpha + ps;
    bf16x8 pa0, pa1;
#define PK4(P, BASE, OUT) do { unsigned a0 = cvt_pk_bf16(P[BASE + 0], P[BASE + 1]), a1 = cvt_pk_bf16(P[BASE + 2], P[BASE + 3]);   \
    unsigned b0 = cvt_pk_bf16(P[BASE + 4], P[BASE + 5]), b1 = cvt_pk_bf16(P[BASE + 6], P[BASE + 7]);                              \
    auto r0 = __builtin_amdgcn_permlane32_swap(a0, b0, false, false); auto r1 = __builtin_amdgcn_permlane32_swap(a1, b1, false, false); \
    u32x4 w = {r0[0], r1[0], r0[1], r1[1]}; OUT = *reinterpret_cast<bf16x8*>(&w); } while (0)
    PK4(p, 0, pa0); PK4(p, 8, pa1);
#undef PK4
    if (__any(alpha < 1.f)) {
        if (hi == 0) al_l[r32] = alpha;
        asm volatile("s_waitcnt lgkmcnt(0)" ::: "memory");
#pragma unroll
        for (int r = 0; r < 16; ++r) { const float a = al_l[crow(r, hi)];
#pragma unroll
            for (int d = 0; d < 4; ++d) o[d][r] *= a; }
    }
    pv_one<0>(o[0], vb, pa0, pa1); pv_one<1>(o[1], vb, pa0, pa1); pv_one<2>(o[2], vb, pa0, pa1); pv_one<3>(o[3], vb, pa0, pa1);
}

__device__ __forceinline__ void attn_prompt_item(const Params& p, LAS unsigned char* lds, int b, int h, int qt) {
    int tid = threadIdx.x; asm volatile("" : "+v"(tid));
    const int wid = __builtin_amdgcn_readfirstlane(tid >> 6), lane = tid & 63, r32 = lane & 31, hi = lane >> 5;
    unsigned char* const wsl = p.ws + opaque0();
    const bf16_t* __restrict__ Z = (const bf16_t*)(wsl + WS_Z);
    bf16_t* __restrict__ MIX = (bf16_t*)(wsl + WS_MIX);
    const int t0 = qt * 256;
    const size_t rowbase = (size_t)b * SEQ;
    LAS float* tab = (LAS float*)(lds + LDS_TAB);
    LAS float* al_l = (LAS float*)(lds + LDS_AL) + wid * 64;
    bf16x8 qr[8];
    { const bf16_t* qp = Z + (rowbase + t0 + 8 * r32 + wid) * LDZ + h * 128 + hi * 8;
#pragma unroll
      for (int d0 = 0; d0 < 8; ++d0) qr[d0] = *(const bf16x8*)(qp + 16 * d0); }
    size_t kofs, vofs;
    { const int rowK = 4 * wid + (lane >> 4), colB = (16 * (lane & 15)) ^ ((rowK & 7) << 4);
      kofs = (size_t)(4 * rowK) * LDZ + 1536 + h * 128 + (colB >> 1);
      const int st = 2 * wid + (lane >> 5), kk = ((st >> 2) << 3) | ((lane & 31) >> 2), k = (kk & ~0xC) | ((kk & 4) << 1) | ((kk & 8) >> 1), cc = 32 * (st & 3) + 8 * (lane & 3);
      vofs = (size_t)(4 * k) * LDZ + 3072 + h * 128 + cc; }
    const bf16_t* zb = Z + rowbase * LDZ;
#define STAGE(c, bsel) do { const bf16_t* g_ = zb + (size_t)(c) * 128 * LDZ; LAS unsigned char* d_ = lds + (bsel) * 65536 + wid * 1024; \
        _Pragma("unroll") for (int g2 = 0; g2 < 4; ++g2) { \
            __builtin_amdgcn_global_load_lds((const unsigned*)(g_ + kofs + (size_t)g2 * LDZ), (LAS unsigned*)(d_ + g2 * 8192), 16, 0, 0); \
            __builtin_amdgcn_global_load_lds((const unsigned*)(g_ + vofs + (size_t)g2 * LDZ), (LAS unsigned*)(d_ + 32768 + g2 * 8192), 16, 0, 0); } } while (0)
    f32x16 o[4] = {}; float m_reg = -1e20f, l_reg = 0.f;
    const int nch = 2 * qt + 2;
    STAGE(0, 0);
    { const float* tg = (const float*)(wsl + WS_TAB) + h * TAB_N; for (int i = tid; i < TAB_N; i += 512) tab[i] = tg[i]; }
    asm volatile("s_waitcnt vmcnt(0)" ::: "memory");
    __syncthreads();
    const int vrb = v_rd_base(lane);
    for (int c = 0; c < nch; ++c) {
        if (c + 1 < nch) STAGE(c + 1, (c + 1) & 1);
        const int bsel = c & 1, p0 = c * 128;
        const bool is_near = (c >= 2 * qt - 1);
        const int tib0 = t0 + 8 * r32 + wid - p0 + TAB_NEG - 16 * hi;
        const LAS unsigned char* kbuf = lds + bsel * 65536;
        const int vbuf = (int)(unsigned)(size_t)(lds + bsel * 65536 + 32768) + vrb;
        if (is_near) {
#pragma unroll 1
            for (int g = 0; g < 4; ++g) attn_tile(kbuf + g * 8192, vbuf + g * 8192, qr, tab + (tib0 - g), o, m_reg, l_reg, al_l, r32, hi);
        } else {
            const int g = wid & 3;
            attn_tile(kbuf + g * 8192, vbuf + g * 8192, qr, tab + (tib0 - g), o, m_reg, l_reg, al_l, r32, hi);
        }
        asm volatile("s_waitcnt vmcnt(0)" ::: "memory");
        __syncthreads();
    }
#undef STAGE
    if (hi == 0) al_l[32 + r32] = l_reg;
    asm volatile("s_waitcnt lgkmcnt(0)" ::: "memory");
    LAS float* ot = (LAS float*)(lds + wid * 16384);
#pragma unroll
    for (int r = 0; r < 16; ++r) { const int qi = crow(r, hi); const float rl = __builtin_amdgcn_rcpf(al_l[32 + qi]);
#pragma unroll
        for (int d0 = 0; d0 < 4; ++d0) ot[qi * 128 + 32 * d0 + r32] = o[d0][r] * rl; }
    asm volatile("s_waitcnt lgkmcnt(0)" ::: "memory");
    {
        u32x4 gv[8];
#pragma unroll
        for (int i = 0; i < 8; ++i) { const int id = lane + 64 * i, row = id >> 4, c8 = id & 15; const size_t m = rowbase + t0 + 8 * row + wid;
            gv[i] = *(const u32x4*)(Z + m * LDZ + 4608 + h * 128 + 8 * c8); }
        __builtin_amdgcn_sched_barrier(0);
#pragma unroll
        for (int i = 0; i < 8; ++i) { const int id = lane + 64 * i, row = id >> 4, c8 = id & 15; const size_t m = rowbase + t0 + 8 * row + wid;
            const f32x4 x0 = *(const LAS f32x4*)(ot + row * 128 + 8 * c8), x1 = *(const LAS f32x4*)(ot + row * 128 + 8 * c8 + 4);
            u32x4 w;
            w.x = cvt_pk_bf16(x0.x * __uint_as_float(gv[i].x << 16), x0.y * __uint_as_float(gv[i].x & 0xffff0000u));
            w.y = cvt_pk_bf16(x0.z * __uint_as_float(gv[i].y << 16), x0.w * __uint_as_float(gv[i].y & 0xffff0000u));
            w.z = cvt_pk_bf16(x1.x * __uint_as_float(gv[i].z << 16), x1.y * __uint_as_float(gv[i].z & 0xffff0000u));
            w.w = cvt_pk_bf16(x1.z * __uint_as_float(gv[i].w << 16), x1.w * __uint_as_float(gv[i].w & 0xffff0000u));
            *(u32x4*)(MIX + m * DM + h * 128 + 8 * c8) = w; }
    }
    __syncthreads();
}

template <int N> __device__ __forceinline__ float dpp_ror_add(float x) {
    return x + __int_as_float(__builtin_amdgcn_update_dpp(0, __float_as_int(x), 0x120 + N, 0xf, 0xf, false));
}
__device__ __forceinline__ float row_allsum16(float x) { x = dpp_ror_add<8>(x); x = dpp_ror_add<4>(x); x = dpp_ror_add<2>(x); x = dpp_ror_add<1>(x); return x; }
__device__ __forceinline__ void attn_sample_item(const Params& p, LAS unsigned char* lds, int b, int h) {
    int tid = threadIdx.x; asm volatile("" : "+v"(tid));
    const int g = tid >> 4, l16 = tid & 15;
    const size_t oz = opaque0();
    unsigned char* const wsl = p.ws + oz; float* const outl = p.out + oz; const float* const ckv = p.in[3] + oz;
    const bf16_t* __restrict__ Z = (const bf16_t*)(wsl + WS_Z);
    bf16_t* __restrict__ MIX = (bf16_t*)(wsl + WS_MIX);
    LAS float* mo = (LAS float*)lds;
    LAS float* ml = (LAS float*)(lds + 65536);
    LAS float* tab = (LAS float*)(lds + LDS_TAB);
    { const float* tg = (const float*)(wsl + WS_TAB) + h * TAB_N; for (int i = tid; i < TAB_N; i += 512) tab[i] = tg[i]; }
    float q[4][8];
#pragma unroll
    for (int j = 0; j < 4; ++j) { const bf16_t* qp = Z + (size_t)(NPR + b * 4 + j) * LDZ + h * 128 + 4 * l16;
        const u32x2 w0 = *(const u32x2*)qp, w1 = *(const u32x2*)(qp + 64);
        q[j][0] = __uint_as_float(w0.x << 16); q[j][1] = __uint_as_float(w0.x & 0xffff0000u); q[j][2] = __uint_as_float(w0.y << 16); q[j][3] = __uint_as_float(w0.y & 0xffff0000u);
        q[j][4] = __uint_as_float(w1.x << 16); q[j][5] = __uint_as_float(w1.x & 0xffff0000u); q[j][6] = __uint_as_float(w1.y << 16); q[j][7] = __uint_as_float(w1.y & 0xffff0000u); }
    const float* __restrict__ ck = ckv + (size_t)b * 2048 * 3072 + h * 128 + 4 * l16;
    const __amdgpu_buffer_rsrc_t crs = __builtin_amdgcn_make_buffer_rsrc((void*)p.in[3], 0, 0x7fffffff, 0x00027000);
    const unsigned cko = (unsigned)(((size_t)b * 2048 * 3072 + h * 128 + 4 * l16) * 4);
    const float* __restrict__ nk = outl + O_KVS + (size_t)b * 2048 * 3072 + h * 128 + 4 * l16;
    float* nkw = outl + O_KVS + (size_t)b * 2048 * 3072 + h * 128 + 4 * l16;
    float m_[4], l_[4], o[4][8];
#pragma unroll
    for (int j = 0; j < 4; ++j) { m_[j] = -1e20f; l_[j] = 0.f;
#pragma unroll
        for (int d = 0; d < 8; ++d) o[j][d] = 0.f; }
    __syncthreads();
#define SA_ROWS(NR, KA, KB, VA, VB, SS) do { \
        float sc_[NR][4]; \
        _Pragma("unroll") for (int u = 0; u < NR; ++u) _Pragma("unroll") for (int j = 0; j < 4; ++j) { \
            float d = q[j][0] * KA[u].x + q[j][1] * KA[u].y + q[j][2] * KA[u].z + q[j][3] * KA[u].w + q[j][4] * KB[u].x + q[j][5] * KB[u].y + q[j][6] * KB[u].z + q[j][7] * KB[u].w; \
            sc_[u][j] = row_allsum16(d) + tab[2048 + TAB_NEG + j - SS[u]]; } \
        _Pragma("unroll") for (int j = 0; j < 4; ++j) { float mx = sc_[0][j]; _Pragma("unroll") for (int u = 1; u < NR; ++u) mx = fmaxf(mx, sc_[u][j]); \
            const float mn = fmaxf(m_[j], mx), al = __builtin_amdgcn_exp2f(m_[j] - mn); m_[j] = mn; l_[j] *= al; \
            _Pragma("unroll") for (int d = 0; d < 8; ++d) o[j][d] *= al; \
            _Pragma("unroll") for (int u = 0; u < NR; ++u) { const float pe = __builtin_amdgcn_exp2f(sc_[u][j] - mn); l_[j] += pe; \
                o[j][0] += pe * VA[u].x; o[j][1] += pe * VA[u].y; o[j][2] += pe * VA[u].z; o[j][3] += pe * VA[u].w; \
                o[j][4] += pe * VB[u].x; o[j][5] += pe * VB[u].y; o[j][6] += pe * VB[u].z; o[j][7] += pe * VB[u].w; } } } while (0)
#pragma unroll 1
    for (int kb = 0; kb < 7; ++kb) {
        f32x4 ka[4], kc[4], va[4], vc[4]; int ss[4];
#pragma unroll
        for (int u = 0; u < 4; ++u) { const int n = g + 32 * (kb * 4 + u); ss[u] = n < 384 ? ((n >> 2) << 4) + (n & 3) : n + 1152;
            const unsigned ro = cko + (unsigned)ss[u] * 12288u;
            ka[u] = __builtin_bit_cast(f32x4, __builtin_amdgcn_raw_buffer_load_b128(crs, ro, 0, 19)); kc[u] = __builtin_bit_cast(f32x4, __builtin_amdgcn_raw_buffer_load_b128(crs, ro + 256u, 0, 19));
            va[u] = __builtin_bit_cast(f32x4, __builtin_amdgcn_raw_buffer_load_b128(crs, ro + 6144u, 0, 19)); vc[u] = __builtin_bit_cast(f32x4, __builtin_amdgcn_raw_buffer_load_b128(crs, ro + 6400u, 0, 19)); }
        __builtin_amdgcn_sched_barrier(0);
        SA_ROWS(4, ka, kc, va, vc, ss);
#pragma unroll
        for (int u = 0; u < 4; ++u) asm volatile("" :: "v"(ka[u]), "v"(kc[u]), "v"(va[u]), "v"(vc[u]));
        __builtin_amdgcn_sched_barrier(0);
#pragma unroll
        for (int u = 0; u < 4; ++u) if (ss[u] >= 4) {
            float* wp = nkw + (size_t)(ss[u] - 4) * 3072;
            st16_hidden_nt(wp, ka[u]); st16_hidden_nt(wp + 64, kc[u]); st16_hidden_nt(wp + 1536, va[u]); st16_hidden_nt(wp + 1600, vc[u]); }
#pragma unroll
        for (int u = 0; u < 4; ++u) asm volatile("" :: "v"(ka[u]), "v"(kc[u]), "v"(va[u]), "v"(vc[u]));
    }
    if (g < 4) {
        f32x4 ka[1], kc[1], va[1], vc[1]; int ss[1]; ss[0] = 2048 + g;
        const float* rp = nk + (size_t)(2044 + g) * 3072;
        ka[0] = *(const f32x4*)rp; kc[0] = *(const f32x4*)(rp + 64); va[0] = *(const f32x4*)(rp + 1536); vc[0] = *(const f32x4*)(rp + 1600);
        SA_ROWS(1, ka, kc, va, vc, ss);
    }
#undef SA_ROWS
#pragma unroll
    for (int j = 0; j < 4; ++j) { LAS float* op = mo + (g * 4 + j) * 128 + 4 * l16;
        *(LAS f32x4*)op = (f32x4){o[j][0], o[j][1], o[j][2], o[j][3]}; *(LAS f32x4*)(op + 64) = (f32x4){o[j][4], o[j][5], o[j][6], o[j][7]};
        if (l16 == 0) { ml[(g * 4 + j) * 2] = m_[j]; ml[(g * 4 + j) * 2 + 1] = l_[j]; } }
    __syncthreads();
    { const int j = tid >> 7, dh = tid & 127; float M = -1e20f;
#pragma unroll 8
      for (int k = 0; k < 32; ++k) M = fmaxf(M, ml[(k * 4 + j) * 2]);
      float num = 0.f, den = 0.f;
#pragma unroll 8
      for (int k = 0; k < 32; ++k) { const float wgt = __builtin_amdgcn_exp2f(ml[(k * 4 + j) * 2] - M); num += wgt * mo[(k * 4 + j) * 128 + dh]; den += wgt * ml[(k * 4 + j) * 2 + 1]; }
      const size_t m = (size_t)NPR + b * 4 + j;
      MIX[m * DM + h * 128 + dh] = f2bf(num / den * bf2f(Z[m * LDZ + 4608 + h * 128 + dh])); }
    __syncthreads();
}

__device__ __forceinline__ void conv_item(const Params& p, LAS unsigned char* lds, int tile, const int stages = 7) {
    int tid = threadIdx.x; asm volatile("" : "+v"(tid));
    const int wid = __builtin_amdgcn_readfirstlane(tid >> 6), lane = tid & 63, r32 = lane & 31, hi = lane >> 5;
    LAS float* cbuf = (LAS float*)lds;
    const size_t oz = opaque0();
    unsigned char* const wsl = p.ws + oz;
    const float* const dww = p.in[7] + oz; const float* const dwb = p.in[8] + oz; const float* const lng = p.in[9] + oz; const float* const lnb = p.in[10] + oz; const float* const pwb = p.in[12] + oz;
    const bf16_t* __restrict__ GC = (const bf16_t*)(wsl + WS_GC);
    bf16_t* __restrict__ MIX = (bf16_t*)(wsl + WS_MIX);
    size_t mbase = 0;
    if (stages & 1)
    {
        typedef float f32x2 __attribute__((ext_vector_type(2)));
        const int cp = tid & 255, th = tid >> 8;
        f32x2 w[31];
#pragma unroll
        for (int j = 0; j < 31; ++j) w[j] = *(const f32x2*)(dww + j * 512 + 2 * cp);
        const f32x2 bias = *(const f32x2*)(dwb + 2 * cp);
#define CV_UNPACK(u) ((f32x2){__uint_as_float((u) << 16), __uint_as_float((u) & 0xffff0000u)})
        if (tile < 128) {
            const int b = tile >> 5, t0 = (tile & 31) * 64; mbase = (size_t)b * SEQ + t0;
            const unsigned* __restrict__ up = (const unsigned*)((const bf16_t*)(wsl + WS_UPP) + ((size_t)b * 2078 + t0 + 32 * th) * 512) + cp;
            unsigned raw[38];
#pragma unroll
            for (int i = 0; i < 38; ++i) raw[i] = up[(size_t)i * 256];
            __builtin_amdgcn_sched_barrier(0);
            f32x2 win[38];
#pragma unroll
            for (int i = 0; i < 38; ++i) win[i] = CV_UNPACK(raw[i]);
#pragma unroll 1
            for (int g = 0; g < 4; ++g) {
                unsigned nx[8];
                const unsigned* un = up + (size_t)(8 * (g < 3 ? g + 1 : g) + 30) * 256;
#pragma unroll
                for (int i = 0; i < 8; ++i) nx[i] = un[(size_t)i * 256];
                __builtin_amdgcn_sched_barrier(0);
#pragma unroll
                for (int o = 0; o < 8; ++o) { f32x2 a = bias;
#pragma unroll
                    for (int j = 0; j < 31; ++j) a += w[j] * win[o + j];
                    *(LAS f32x2*)(cbuf + (32 * th + 8 * g + o) * 512 + 2 * cp) = a; }
#pragma unroll
                for (int i = 0; i < 30; ++i) win[i] = win[i + 8];
#pragma unroll
                for (int i = 0; i < 8; ++i) win[30 + i] = CV_UNPACK(nx[i]);
            }
        } else {
            const int bb0 = (tile - 128) * 16; mbase = (size_t)NPR + bb0 * 4;
            const unsigned* __restrict__ up = (const unsigned*)((const bf16_t*)(wsl + WS_UPS) + (size_t)(bb0 + 8 * th) * 34 * 512) + cp;
            unsigned raw[34];
#pragma unroll
            for (int i = 0; i < 34; ++i) raw[i] = up[(size_t)i * 256];
#pragma unroll 1
            for (int bb = 0; bb < 8; ++bb) {
                f32x2 win[34];
#pragma unroll
                for (int i = 0; i < 34; ++i) win[i] = CV_UNPACK(raw[i]);
                const unsigned* un = up + (size_t)((bb < 7 ? bb + 1 : bb) * 34) * 256;
#pragma unroll
                for (int i = 0; i < 34; ++i) raw[i] = un[(size_t)i * 256];
                __builtin_amdgcn_sched_barrier(0);
#pragma unroll
                for (int o = 0; o < 4; ++o) { f32x2 a = bias;
#pragma unroll
                    for (int j = 0; j < 31; ++j) a += w[j] * win[o + j];
                    *(LAS f32x2*)(cbuf + ((8 * th + bb) * 4 + o) * 512 + 2 * cp) = a; }
            }
        }
#undef CV_UNPACK
    }
    __syncthreads();
    if (stages & 2)
    {
        const f32x4 g0 = *(const f32x4*)(lng + 8 * lane), g1 = *(const f32x4*)(lng + 8 * lane + 4);
        const f32x4 b0 = *(const f32x4*)(lnb + 8 * lane), b1 = *(const f32x4*)(lnb + 8 * lane + 4);
#pragma unroll 2
        for (int tk = 0; tk < 8; ++tk) {
            const int row = 8 * wid + tk;
            f32x4 x0 = *(const LAS f32x4*)(cbuf + row * 512 + 8 * lane), x1 = *(const LAS f32x4*)(cbuf + row * 512 + 8 * lane + 4);
            const float mu = wave_sum((x0.x + x0.y) + (x0.z + x0.w) + (x1.x + x1.y) + (x1.z + x1.w)) * (1.f / 512.f);
            x0 = x0 - mu; x1 = x1 - mu;
            const float var = wave_sum((x0.x * x0.x + x0.y * x0.y) + (x0.z * x0.z + x0.w * x0.w) + (x1.x * x1.x + x1.y * x1.y) + (x1.z * x1.z + x1.w * x1.w)) * (1.f / 512.f);
            const float rstd = 1.0f / sqrtf(var + EPS);
            x0 = x0 * rstd * g0 + b0; x1 = x1 * rstd * g1 + b1;
#pragma unroll
            for (int j = 0; j < 4; ++j) { x0[j] = silu_f(x0[j]); x1[j] = silu_f(x1[j]); }
            u32x4 wv; wv.x = cvt_pk_bf16(x0[0], x0[1]); wv.y = cvt_pk_bf16(x0[2], x0[3]); wv.z = cvt_pk_bf16(x1[0], x1[1]); wv.w = cvt_pk_bf16(x1[2], x1[3]);
            *(LAS u32x4*)((LAS unsigned char*)cbuf + row * 2048 + ((lane ^ (row & 15)) << 4)) = wv;
        }
    }
    __syncthreads();
    if (stages & 4)
    {
        const bf16_t* __restrict__ WT = (const bf16_t*)(wsl + WS_WPW);
        const bf16_t* wp0 = WT + (size_t)(64 * wid + r32) * 512 + 8 * hi; const bf16_t* wp1 = wp0 + 32 * 512;
        const LAS unsigned char* ab = (const LAS unsigned char*)cbuf;
        f32x16 acc[2][2] = {};
#define PW_LOAD(F0, F1, S8) do { _Pragma("unroll") for (int u = 0; u < 8; ++u) { F0[u] = *(const bf16x8*)(wp0 + 16 * ((S8) + u)); F1[u] = *(const bf16x8*)(wp1 + 16 * ((S8) + u)); } } while (0)
#define PW_MMA(F0, F1, S8) do { _Pragma("unroll") for (int u = 0; u < 8; ++u) { const int s = (S8) + u; \
                const bf16x8 a0 = *(const LAS bf16x8*)(ab + r32 * 2048 + (((2 * s + hi) ^ (r32 & 15)) << 4)); \
                const bf16x8 a1 = *(const LAS bf16x8*)(ab + (32 + r32) * 2048 + (((2 * s + hi) ^ (r32 & 15)) << 4)); \
                acc[0][0] = __builtin_amdgcn_mfma_f32_32x32x16_bf16(a0, F0[u], acc[0][0], 0, 0, 0); \
                acc[0][1] = __builtin_amdgcn_mfma_f32_32x32x16_bf16(a0, F1[u], acc[0][1], 0, 0, 0); \
                acc[1][0] = __builtin_amdgcn_mfma_f32_32x32x16_bf16(a1, F0[u], acc[1][0], 0, 0, 0); \
                acc[1][1] = __builtin_amdgcn_mfma_f32_32x32x16_bf16(a1, F1[u], acc[1][1], 0, 0, 0); } } while (0)
        {
            bf16x8 fa0[8], fa1[8], fb0[8], fb1[8];
            PW_LOAD(fa0, fa1, 0);
            __builtin_amdgcn_sched_barrier(0);
            PW_LOAD(fb0, fb1, 8);
            __builtin_amdgcn_sched_barrier(0);
            PW_MMA(fa0, fa1, 0);
            __builtin_amdgcn_sched_barrier(0);
            PW_LOAD(fa0, fa1, 16);
            __builtin_amdgcn_sched_barrier(0);
            PW_MMA(fb0, fb1, 8);
            __builtin_amdgcn_sched_barrier(0);
            PW_LOAD(fb0, fb1, 24);
            __builtin_amdgcn_sched_barrier(0);
            PW_MMA(fa0, fa1, 16);
            __builtin_amdgcn_sched_barrier(0);
            PW_MMA(fb0, fb1, 24);
        }
#undef PW_LOAD
#undef PW_MMA
        __syncthreads();
#pragma unroll
        for (int ct = 0; ct < 2; ++ct) { const int e = 64 * wid + 32 * ct + r32; const float pb = pwb[e];
#pragma unroll
            for (int rt = 0; rt < 2; ++rt)
#pragma unroll
                for (int r = 0; r < 16; ++r) cbuf[(32 * rt + crow(r, hi)) * 512 + e] = acc[rt][ct][r] + pb; }
        __syncthreads();
        u32x4 gv[8];
#pragma unroll
        for (int i = 0; i < 8; ++i) { const int id = tid + 512 * i, row = id >> 6, c8 = id & 63; gv[i] = *(const u32x4*)(GC + (mbase + row) * 512 + 8 * c8); }
        __builtin_amdgcn_sched_barrier(0);
#pragma unroll
        for (int i = 0; i < 8; ++i) { const int id = tid + 512 * i, row = id >> 6, c8 = id & 63;
            const f32x4 x0 = *(const LAS f32x4*)(cbuf + row * 512 + 8 * c8), x1 = *(const LAS f32x4*)(cbuf + row * 512 + 8 * c8 + 4);
            u32x4 wv;
            wv.x = cvt_pk_bf16(x0.x * __uint_as_float(gv[i].x << 16), x0.y * __uint_as_float(gv[i].x & 0xffff0000u));
            wv.y = cvt_pk_bf16(x0.z * __uint_as_float(gv[i].y << 16), x0.w * __uint_as_float(gv[i].y & 0xffff0000u));
            wv.z = cvt_pk_bf16(x1.x * __uint_as_float(gv[i].z << 16), x1.y * __uint_as_float(gv[i].z & 0xffff0000u));
            wv.w = cvt_pk_bf16(x1.z * __uint_as_float(gv[i].w << 16), x1.w * __uint_as_float(gv[i].w & 0xffff0000u));
            *(u32x4*)(MIX + (mbase + row) * DM + 1536 + 8 * c8) = wv; }
    }
    __syncthreads();
}

constexpr int N_PA = 384, N_SA = 384, N_CV = 130, N_ITEMS = N_PA + N_SA + N_CV;
__device__ __forceinline__ void p2_phase(const Params& p, LAS unsigned char* lds, const int mask = 7) {
    unsigned* head = (unsigned*)(p.ws + WS_CTL) + 64;
    volatile LAS int* slot = (volatile LAS int*)(lds + LDS_MISC);
    unsigned* donec = (unsigned*)(p.ws + WS_CTL) + 128;
    unsigned prev = 0u;
    for (;;) {
        if (threadIdx.x == 0) { if (prev) atomicAdd(donec, prev); slot[0] = (int)atomicAdd(head, 1u); }
        prev = 1u;
        __syncthreads();
        const int it = __builtin_amdgcn_readfirstlane(slot[0]);
        __syncthreads();
        if (it >= N_ITEMS) break;
        if (it < N_CV) { if (mask & 4) conv_item(p, lds, it); }
        else {
            const int j = it - N_CV; int pa = -1, sa = -1;
            if (j < 192) { if (j & 1) sa = j >> 1; else pa = j >> 1; }
            else if (j < 192 + 432) { const int r = j - 192, t3 = r / 3, m3 = r % 3; if (m3 == 2) pa = 96 + t3; else sa = 96 + 2 * t3 + m3; }
            else pa = 240 + (j - 624);
            if (pa >= 0) { const int qt = 7 - pa / 48, rem = pa % 48; if (mask & 1) attn_prompt_item(p, lds, rem / 12, rem % 12, qt); }
            else { if (mask & 2) attn_sample_item(p, lds, sa / 12, sa % 12); } }
    }
    unsigned* phead = (unsigned*)(p.ws + WS_CTL) + 192;
    for (;;) {
        __syncthreads();
        if (threadIdx.x == 0) slot[0] = (__hip_atomic_load(donec, __ATOMIC_RELAXED, __HIP_MEMORY_SCOPE_AGENT) >= (unsigned)N_ITEMS) ? CP_POOL : (int)atomicAdd(phead, 1u);
        __syncthreads();
        const int q = __builtin_amdgcn_readfirstlane(slot[0]);
        if (q >= CP_POOL) break;
        CopyBurst cb; cb.init(p.in[3], p.out + O_KVS, 0); cb.burst(q / (12 - CP_STATIC), CP_STATIC + q % (12 - CP_STATIC), CP_STATIC + q % (12 - CP_STATIC) + 1);
    }
}

__device__ __forceinline__ void pool_idle(const Params& p, LAS unsigned char* lds, const int cw, const unsigned total) {
    unsigned* donec = (unsigned*)(p.ws + WS_CTL) + cw;
    unsigned* phead = (unsigned*)(p.ws + WS_CTL) + 192;
    volatile LAS int* slot = (volatile LAS int*)(lds + LDS_MISC);
    unsigned first = 1u;
    for (;;) {
        __syncthreads();
        if (threadIdx.x == 0) { if (first) atomicAdd(donec, 1u);
            slot[0] = (__hip_atomic_load(donec, __ATOMIC_RELAXED, __HIP_MEMORY_SCOPE_AGENT) >= total) ? CP_POOL : (int)atomicAdd(phead, 1u); }
        first = 0u;
        __syncthreads();
        const int q = __builtin_amdgcn_readfirstlane(slot[0]);
        if (q >= CP_POOL) break;
        CopyBurst cb; cb.init(p.in[3], p.out + O_KVS, 0); cb.burst(q / (12 - CP_STATIC), CP_STATIC + q % (12 - CP_STATIC), CP_STATIC + q % (12 - CP_STATIC) + 1);
    }
}

__device__ __forceinline__ void pool_drain(const Params& p, LAS unsigned char* lds, const int quota) {
    unsigned* head = (unsigned*)(p.ws + WS_CTL) + 192;
    volatile LAS int* slot = (volatile LAS int*)(lds + LDS_MISC);
    for (int n = 0; n < quota; ++n) {
        __syncthreads();
        if (threadIdx.x == 0) slot[0] = (int)atomicAdd(head, 1u);
        __syncthreads();
        const int q = __builtin_amdgcn_readfirstlane(slot[0]);
        if (q >= CP_POOL) break;
        CopyBurst cb; cb.init(p.in[3], p.out + O_KVS, 0); cb.burst(q / (12 - CP_STATIC), CP_STATIC + q % (12 - CP_STATIC), CP_STATIC + q % (12 - CP_STATIC) + 1);
    }
}

__device__ __forceinline__ void sample_slice(const Params& p, LAS unsigned char* lds) {
    const int blk = blockIdx.x, rb = blk >> 6, cb = blk & 63;
    const int tid = threadIdx.x, wid = tid >> 6, lane = tid & 63, l15 = lane & 15, kg = lane >> 4;
    float* __restrict__ Y = (float*)(p.ws + WS_Y);
    unsigned* cnt = (unsigned*)(p.ws + WS_CTL) + CW_SAMPLE;
    const bf16_t* __restrict__ A = (const bf16_t*)(p.ws + WS_MIX) + (size_t)(NPR + 32 * rb + l15) * DM + 256 * wid + 8 * kg;
    const bf16_t* __restrict__ B = (const bf16_t*)(p.ws + WS_WOUT) + (size_t)(32 * cb + l15) * DM + 256 * wid + 8 * kg;
    bf16x8 a[2][8], bq[2][8];
#pragma unroll
    for (int t = 0; t < 2; ++t)
#pragma unroll
        for (int s = 0; s < 8; ++s) { a[t][s] = *(const bf16x8*)(A + (size_t)(16 * t) * DM + 32 * s); bq[t][s] = *(const bf16x8*)(B + (size_t)(16 * t) * DM + 32 * s); }
    __builtin_amdgcn_sched_barrier(0);
    LAS float* part = (LAS float*)lds + wid * 1056;
#pragma unroll
    for (int rt = 0; rt < 2; ++rt)
#pragma unroll
        for (int ct = 0; ct < 2; ++ct) { f32x4 acc = {0.f, 0.f, 0.f, 0.f};
#pragma unroll
            for (int s = 0; s < 8; ++s) acc = __builtin_amdgcn_mfma_f32_16x16x32_bf16(a[rt][s], bq[ct][s], acc, 0, 0, 0);
#pragma unroll
            for (int r = 0; r < 4; ++r) part[(16 * rt + 4 * kg + r) * 33 + 16 * ct + l15] = acc[r]; }
    __syncthreads();
#pragma unroll
    for (int i = 0; i < 2; ++i) { const int o = tid + 512 * i, row = o >> 5, c = o & 31; float sum = 0.f;
#pragma unroll
        for (int w = 0; w < 8; ++w) sum += ((LAS float*)lds)[w * 1056 + row * 33 + c];
        Y[(size_t)(NPR + 32 * rb + row) * DM + 32 * cb + c] = sum; }
    asm volatile("s_waitcnt vmcnt(0)" ::: "memory");
    __syncthreads();
    if (tid == 0) { __builtin_amdgcn_fence(__ATOMIC_RELEASE, "agent"); asm volatile("s_waitcnt vmcnt(0)" ::: "memory");
        __hip_atomic_fetch_add(cnt, 1u, __ATOMIC_RELAXED, __HIP_MEMORY_SCOPE_AGENT); }
}
__device__ __forceinline__ void sample_final(const Params& p) {
    const int blk = blockIdx.x, tid = threadIdx.x, wid = tid >> 6, lane = tid & 63;
    if (blk >= 128 || wid != 0) return;
    const float* __restrict__ Y = (const float*)(p.ws + WS_Y);
    unsigned* cnt = (unsigned*)(p.ws + WS_CTL) + CW_SAMPLE;
    const int i = blk; unsigned sp = 0;
    while ((unsigned)__builtin_amdgcn_readfirstlane(__hip_atomic_load(cnt, __ATOMIC_RELAXED, __HIP_MEMORY_SCOPE_AGENT)) < gridDim.x) { __builtin_amdgcn_s_sleep(4); if (++sp > (1u << 20)) break; }
    __builtin_amdgcn_fence(__ATOMIC_ACQUIRE, "agent");
    asm volatile("s_waitcnt vmcnt(0)" ::: "memory");
    const f32x4* yr = (const f32x4*)(Y + (size_t)(NPR + i) * DM) + lane;
    const f32x4* xr = (const f32x4*)(p.in[1] + (size_t)i * DM) + lane;
    const f32x4* gp = (const f32x4*)p.in[14] + lane;
    f32x4* orow = (f32x4*)(p.out + O_YS + (size_t)i * DM) + lane;
    f32x4 v[8], xv[8], gv[8]; float s = 0.f;
#pragma unroll
    for (int j = 0; j < 8; ++j) { v[j] = yr[64 * j]; xv[j] = xr[64 * j]; gv[j] = gp[64 * j]; }
    __builtin_amdgcn_sched_barrier(0);
#pragma unroll
    for (int j = 0; j < 8; ++j) s += (v[j].x * v[j].x + v[j].y * v[j].y) + (v[j].z * v[j].z + v[j].w * v[j].w);
    const float rstd = 1.0f / sqrtf(wave_sum(s) * (1.f / DM) + EPS);
#pragma unroll
    for (int j = 0; j < 8; ++j) orow[64 * j] = xv[j] + v[j] * rstd * gv[j];
}

__device__ __forceinline__ void p4_final(const Params& p) {
    const int tid = threadIdx.x, lane = tid & 63, wave = tid >> 6;
    const int gw = blockIdx.x * 8 + wave, NGW = gridDim.x * 8;
    const float* Y = (const float*)(p.ws + WS_Y);
    const f32x4* gp = (const f32x4*)p.in[14] + lane;
    for (int m = gw; m < MROWS; m += NGW) {
        const f32x4* yr = (const f32x4*)(Y + (size_t)m * DM) + lane;
        const f32x4* xr = (const f32x4*)(m < NPR ? p.in[0] + (size_t)m * DM : p.in[1] + (size_t)(m - NPR) * DM) + lane;
        f32x4* orow = (f32x4*)(m < NPR ? p.out + O_YP + (size_t)m * DM : p.out + O_YS + (size_t)(m - NPR) * DM) + lane;
        f32x4 v[8]; float s = 0.f;
#pragma unroll
        for (int j = 0; j < 8; ++j) { v[j] = yr[64 * j]; s += (v[j].x * v[j].x + v[j].y * v[j].y) + (v[j].z * v[j].z + v[j].w * v[j].w); }
        const float rstd = 1.0f / sqrtf(wave_sum(s) * (1.f / DM) + EPS);
#pragma unroll
        for (int j = 0; j < 8; ++j) orow[64 * j] = xr[64 * j] + v[j] * rstd * gp[64 * j];
    }
}

__global__ void __launch_bounds__(512, 2) mega_fwd(Params p) {
    extern __shared__ __attribute__((aligned(16))) unsigned char lds_raw[];
    LAS unsigned char* lds = (LAS unsigned char*)lds_raw;
    const int lo = p.ph_lo, hi = p.ph_hi;
    if (threadIdx.x < 64) ((LAS unsigned*)(lds + LDS_MISC))[threadIdx.x] = 0u;
    __syncthreads();
    unsigned long long ts0 = 0, ts1 = 0;
    if (PROBE_T == 100) ts0 = __builtin_amdgcn_s_memrealtime();
#define TSTAMP(k) do { if (PROBE_T == (k)) ts0 = __builtin_amdgcn_s_memrealtime(); if (PROBE_T == (k) - 1 && PROBE_T > 0) ts1 = __builtin_amdgcn_s_memrealtime(); } while (0)
    XcdBarrier bar = xcd_barrier_post((unsigned*)(p.ws + WS_CTL) + 1024, (volatile LAS unsigned*)(lds + LDS_MISC) + 8);
#define IN(k) (lo <= (k) && (k) < hi)
#define SEAM(k) do { if (IN(k) && IN((k) + 1)) xcd_barrier(bar); } while (0)
    TSTAMP(1);
    if (PROBE_T == 100) ts1 = __builtin_amdgcn_s_memrealtime();
#ifndef SKIP_P0
    if (IN(0)) p0_prologue(p, lds);
    if (PROBE_DUP == 0) { xcd_barrier(bar); p0_prologue(p, lds); }
#endif
    SEAM(0);
    TSTAMP(2);
#ifndef SKIP_P1
    if (IN(1)) {
        pg8::Gemm g{(const bf16_t*)(p.ws + WS_H), (const bf16_t*)(p.ws + WS_WIN), MPAD, DIN, DM};
        pg8::StaticOrder S; S.init(MPAD, DIN, (int)gridDim.x, (int)blockIdx.x);
        EpiInProj E{(bf16_t*)(p.ws + WS_Z), (bf16_t*)(p.ws + WS_GC), (bf16_t*)(p.ws + WS_UPP), (bf16_t*)(p.ws + WS_UPS), p.out};
        CopyBurst rider; rider.init(p.in[3], p.out + O_KVS, (int)(blockIdx.x >> 3) & 3);
        pg8::gemm_phase<EpiInProj, pg8::StaticOrder, CopyBurst, false>(lds, g, S, E, rider, nullptr);
        rider.finish();
        pool_idle(p, lds, 130, 256u);
    }
#endif
    SEAM(1);
    TSTAMP(3);
#ifndef SKIP_P2
    if (IN(2)) p2_phase(p, lds);
    if (PROBE_DUP == 2) { xcd_barrier(bar); if (blockIdx.x == 0 && threadIdx.x == 0) *((volatile unsigned*)(p.ws + WS_CTL) + 64) = 0u; __threadfence(); xcd_barrier(bar); p2_phase(p, lds, PROBE_MASK); }
#endif
    SEAM(2);
    TSTAMP(4);
#ifndef SKIP_P3
    if (IN(3)) {
        pg8::Gemm g{(const bf16_t*)(p.ws + WS_MIX), (const bf16_t*)(p.ws + WS_WOUT), NPR, DM, DM};
        pg8::StaticOrder S; S.init(NPR, DM, (int)gridDim.x, (int)blockIdx.x);
        EpiOutFused E{p.in[0], p.out + O_YP, p.in[14], (unsigned*)(p.ws + WS_XCH), (unsigned*)(p.ws + WS_CTL)};
        NoRider rider;
        if ((blockIdx.x >> 3) & 1) pool_drain(p, lds, POOL_FIRST);
        sample_slice(p, lds);
        __syncthreads();
        pg8::gemm_phase<EpiOutFused, pg8::StaticOrder, NoRider, false>(lds, g, S, E, rider, nullptr);
        sample_final(p);
        pool_drain(p, lds, CP_POOL);
    }
#endif
    TSTAMP(5);
    TSTAMP(6);
    if (PROBE_T > 0 && blockIdx.x == 0 && threadIdx.x == 0) { const unsigned long long d = ts1 - ts0, t = __builtin_amdgcn_s_memrealtime(); while (__builtin_amdgcn_s_memrealtime() - t < d) __builtin_amdgcn_s_sleep(4); }
#undef IN
#undef SEAM
}

extern "C" void kernel_launch(void* const* d_in, const int* in_sizes, int n_in, void* d_out, int out_size, void* d_ws, size_t ws_size, hipStream_t stream) {
    static int grid = 0;
    if (grid == 0) {
        if (n_in != 15 || out_size != 244084736 || ws_size < WS_END) { fprintf(stderr, "kernel_launch: unexpected shapes (n_in %d out %d ws %zu)\n", n_in, out_size, ws_size); grid = -1; return; }
        int dev = 0, cus = 0, per_cu = 0;
        hipGetDevice(&dev); hipDeviceGetAttribute(&cus, hipDeviceAttributeMultiprocessorCount, dev);
        if (hipFuncSetAttribute((const void*)mega_fwd, hipFuncAttributeMaxDynamicSharedMemorySize, LDS_BYTES) != hipSuccess) { fprintf(stderr, "kernel_launch: hipFuncSetAttribute failed\n"); grid = -1; return; }
        hipOccupancyMaxActiveBlocksPerMultiprocessor(&per_cu, (const void*)mega_fwd, 512, LDS_BYTES);
        if (per_cu < 1) { fprintf(stderr, "kernel_launch: occupancy query says %d blocks/CU\n", per_cu); grid = -1; return; }
        if (cus < 256) { fprintf(stderr, "kernel_launch: built for a 256-CU device (got %d CUs)\n", cus); grid = -1; return; }
        grid = 256;
    }
    if (grid < 0) return;
    hipMemsetAsync((char*)d_ws + WS_CTL, 0, CTL_BYTES, stream);
    Params prm{};
    for (int i = 0; i < 15; ++i) prm.in[i] = (const float*)d_in[i];
    prm.out = (float*)d_out; prm.ws = (unsigned char*)d_ws;
#if MK_N_LAUNCHES == 1
    prm.ph_lo = 0; prm.ph_hi = 5;
    void* args[] = {&prm};
    hipError_t e = hipLaunchCooperativeKernel((const void*)mega_fwd, dim3(grid), dim3(512), args, LDS_BYTES, stream);
    if (e != hipSuccess) fprintf(stderr, "cooperative launch failed: %s (grid %d)\n", hipGetErrorString(e), grid);
#else
    for (int ph = 0; ph < 5; ++ph) { prm.ph_lo = ph; prm.ph_hi = ph + 1; hipLaunchKernelGGL(mega_fwd, dim3(grid), dim3(512), LDS_BYTES, stream, prm); }
#endif
}
```
